# Optimizing an MI355X kernel written in HIP

```python
import math
import jax, jax.numpy as jnp
from jax import lax
import numpy as np

D_MODEL = 1024
BATCH = 4
SEQ = 8192
DEPTH = 1

C_CONV = 512
CONV_WIDTH = 31
N_HEADS = 4
HEAD_DIM = 64
V_DIM = 2 * HEAD_DIM
ATT_WIDTH = N_HEADS * V_DIM
Q_BLOCK = 128
D_FF = 4 * D_MODEL
PLE_DIM = 256
LN_EPS = 1e-5
DEEPNORM_ALPHA = (2.0 * DEPTH) ** 0.25
DEEPNORM_BETA = (8.0 * DEPTH) ** -0.25
N_GLU = 2 * C_CONV
N_QK = N_HEADS * 2 * HEAD_DIM
N_V = ATT_WIDTH
N_GATE = 2 * D_MODEL
N_IN = N_GLU + 2 * N_QK + N_V + N_GATE
SPLITS = (N_GLU, N_GLU + N_QK, N_GLU + 2 * N_QK, N_GLU + 2 * N_QK + N_V, N_GLU + 2 * N_QK + N_V + D_MODEL)
NEG_INF = -1e30

kernel_name = "hybrid_conformer_conv_diff_attn_deepnorm"


def layer_norm(x, g, b):
    xf = x.astype(jnp.float32)
    mu = jnp.mean(xf, axis=-1, keepdims=True)
    var = jnp.mean(jnp.square(xf - mu), axis=-1, keepdims=True)
    y = (xf - mu) * lax.rsqrt(var + LN_EPS)
    return (y * g.astype(jnp.float32) + b.astype(jnp.float32)).astype(x.dtype)


def rms_norm(x, g):
    xf = x.astype(jnp.float32)
    y = xf * lax.rsqrt(jnp.mean(jnp.square(xf), axis=-1, keepdims=True) + LN_EPS)
    return (y * g.astype(jnp.float32)).astype(x.dtype)


def alibi_slopes():
    return 2.0 ** (-8.0 * jnp.arange(1, N_HEADS + 1, dtype=jnp.float32) / N_HEADS)


def conformer_conv(z, w_dw, ln_g, ln_b, w_pw):
    a, g = jnp.split(z, 2, axis=-1)
    u = a * jax.nn.sigmoid(g)
    u = lax.conv_general_dilated(
        u, w_dw[:, None, :].astype(u.dtype), window_strides=(1,),
        padding=[(CONV_WIDTH - 1, 0)],
        dimension_numbers=("NWC", "WIO", "NWC"),
        feature_group_count=C_CONV)
    u = jax.nn.silu(layer_norm(u, ln_g, ln_b))
    return u @ w_pw


def diff_attention(q, k, v, lam):
    B, S = q.shape[0], q.shape[1]
    nb = S // Q_BLOCK
    scale = HEAD_DIM ** -0.5
    qb = (q * scale).reshape(B, nb, Q_BLOCK, N_HEADS, 2, HEAD_DIM).transpose(1, 0, 3, 4, 2, 5)
    kt = k.transpose(0, 2, 3, 1, 4)
    vt = v.transpose(0, 2, 1, 3)
    slopes = alibi_slopes()
    k_pos = jnp.arange(S)

    def block(args):
        q_blk, blk = args
        q_pos = blk * Q_BLOCK + jnp.arange(Q_BLOCK)
        dist = q_pos[:, None] - k_pos[None, :]
        bias = -slopes[:, None, None] * dist.astype(jnp.float32)
        s = jnp.einsum("bhcqd,bhcsd->bhcqs", q_blk, kt).astype(jnp.float32) + bias[None, :, None]
        s = jnp.where(dist >= 0, s, NEG_INF)
        pr = jax.nn.softmax(s, axis=-1)
        a = pr[:, :, 0] - lam * pr[:, :, 1]
        return jnp.einsum("bhqs,bhsv->bhqv", a.astype(vt.dtype), vt)

    o = lax.map(block, (qb, jnp.arange(nb)))
    return o.transpose(1, 0, 3, 2, 4).reshape(B, S, N_HEADS, V_DIM)


def setup_inputs(seed: int = 0) -> dict:
    key = jax.random.key(seed)
    ks = jax.random.split(key, 32)
    f32 = jnp.float32
    nrm = lambda k, shape, s: jax.random.normal(k, shape, f32) * s
    d_s = D_MODEL ** -0.5
    w_in = jnp.concatenate([
        nrm(ks[2], (DEPTH, D_MODEL, N_GLU + 2 * N_QK), d_s),
        nrm(ks[3], (DEPTH, D_MODEL, N_V), d_s * DEEPNORM_BETA),
        nrm(ks[4], (DEPTH, D_MODEL, N_GATE), d_s),
    ], axis=-1)
    return {
        "x": jax.random.normal(ks[0], (BATCH, SEQ, D_MODEL), f32),
        "p": jax.random.normal(ks[1], (DEPTH, BATCH, SEQ, PLE_DIM), f32),
        "ln0_g": 1.0 + nrm(ks[5], (D_MODEL,), 0.02),
        "ln0_b": nrm(ks[6], (D_MODEL,), 0.02),
        "w_in": w_in,
        "conv_w": nrm(ks[7], (DEPTH, CONV_WIDTH, C_CONV), CONV_WIDTH ** -0.5),
        "conv_ln_g": 1.0 + nrm(ks[8], (DEPTH, C_CONV), 0.02),
        "conv_ln_b": nrm(ks[9], (DEPTH, C_CONV), 0.02),
        "w_conv_out": nrm(ks[10], (DEPTH, C_CONV, D_MODEL), C_CONV ** -0.5 * DEEPNORM_BETA),
        "lambda_q1": nrm(ks[11], (DEPTH, HEAD_DIM), 0.1),
        "lambda_k1": nrm(ks[12], (DEPTH, HEAD_DIM), 0.1),
        "lambda_q2": nrm(ks[13], (DEPTH, HEAD_DIM), 0.1),
        "lambda_k2": nrm(ks[14], (DEPTH, HEAD_DIM), 0.1),
        "subln_g": 1.0 + nrm(ks[15], (DEPTH, ATT_WIDTH), 0.02),
        "w_attn_out": nrm(ks[16], (DEPTH, ATT_WIDTH, D_MODEL), ATT_WIDTH ** -0.5 * DEEPNORM_BETA),
        "w_o": nrm(ks[17], (DEPTH, D_MODEL, D_MODEL), d_s * DEEPNORM_BETA),
        "ln1_g": 1.0 + nrm(ks[18], (DEPTH, D_MODEL), 0.02),
        "ln1_b": nrm(ks[19], (DEPTH, D_MODEL), 0.02),
        "w_ff1": nrm(ks[20], (DEPTH, D_MODEL, D_FF), d_s * DEEPNORM_BETA),
        "w_ff2": nrm(ks[21], (DEPTH, D_FF, D_MODEL), D_FF ** -0.5 * DEEPNORM_BETA),
        "w_ple": nrm(ks[22], (DEPTH, PLE_DIM, D_MODEL), PLE_DIM ** -0.5 * DEEPNORM_BETA),
        "w_ple_gate": nrm(ks[23], (DEPTH, D_MODEL, D_MODEL), d_s),
        "ln2_g": 1.0 + nrm(ks[24], (DEPTH, D_MODEL), 0.02),
        "ln2_b": nrm(ks[25], (DEPTH, D_MODEL), 0.02),
    }


def reference(x, p, ln0_g, ln0_b, w_in, conv_w, conv_ln_g, conv_ln_b, w_conv_out,
              lambda_q1, lambda_k1, lambda_q2, lambda_k2, subln_g, w_attn_out, w_o,
              ln1_g, ln1_b, w_ff1, w_ff2, w_ple, w_ple_gate, ln2_g, ln2_b):
    B, S = x.shape[0], x.shape[1]
    h = layer_norm(x, ln0_g, ln0_b)
    for i in range(DEPTH):
        lambda_init = 0.8 - 0.6 * math.exp(-0.3 * i)
        z = h @ w_in[i]
        z_glu, z_q, z_k, z_v, g_conv, g_attn = jnp.split(z, SPLITS, axis=-1)
        y_conv = conformer_conv(z_glu, conv_w[i], conv_ln_g[i], conv_ln_b[i], w_conv_out[i])
        lam = (jnp.exp(jnp.sum(lambda_q1[i].astype(jnp.float32) * lambda_k1[i].astype(jnp.float32)))
               - jnp.exp(jnp.sum(lambda_q2[i].astype(jnp.float32) * lambda_k2[i].astype(jnp.float32)))
               + lambda_init)
        q = z_q.reshape(B, S, N_HEADS, 2, HEAD_DIM)
        k = z_k.reshape(B, S, N_HEADS, 2, HEAD_DIM)
        v = z_v.reshape(B, S, N_HEADS, V_DIM)
        o = diff_attention(q, k, v, lam)
        o = rms_norm(o, subln_g[i].reshape(N_HEADS, V_DIM)) * (1.0 - lambda_init)
        y_attn = o.reshape(B, S, ATT_WIDTH) @ w_attn_out[i]
        merged = jax.nn.sigmoid(g_conv) * y_conv + jax.nn.sigmoid(g_attn) * y_attn
        h = layer_norm(DEEPNORM_ALPHA * h + merged @ w_o[i], ln1_g[i], ln1_b[i])
        ff = jnp.square(jax.nn.relu(h @ w_ff1[i])) @ w_ff2[i]
        ple = jax.nn.sigmoid(h @ w_ple_gate[i]) * (p[i] @ w_ple[i])
        h = layer_norm(DEEPNORM_ALPHA * h + ff + ple, ln2_g[i], ln2_b[i])
    return h
```

```cpp
#include <hip/hip_runtime.h>
#include <hip/hip_cooperative_groups.h>
#include <cstdio>
#include <cstdint>
namespace cg = cooperative_groups;
namespace pg8 {
#define PG8_LAS __attribute__((address_space(3)))
typedef unsigned short bf16_t;
typedef short bf16x8 __attribute__((ext_vector_type(8)));
typedef float f32x4 __attribute__((ext_vector_type(4)));
typedef unsigned u32x4 __attribute__((ext_vector_type(4)));
constexpr int BM = 256, BK = 64, HALF = 128, HTB = HALF * BK * 2  , STAGE_BYTES = 8 * HTB, NXCD = 8, WGM = 8;

__host__ __device__ __forceinline__ int lds_byte(int r, int c) { const int st = (r >> 4) * 2 + (c >> 5), rr = r & 15, cc = c & 31, ob = rr * 64 + cc * 2; return st * 1024 + (ob ^ (((ob >> 9) & 1) << 5)); }
__host__ __device__ __forceinline__ void stage_rc(int b, int& R, int& C) { const int st = b / 1024, sb = b % 1024, swz = sb ^ (((sb >> 9) & 1) << 5); R = (st >> 1) * 16 + swz / 64; C = (st & 1) * 32 + (swz % 64) / 2; }
__host__ __device__ __forceinline__ int perm32(int rho) { const int n = rho >> 4, i = rho & 15; return 8 * (i >> 2) + 4 * n + (i & 3); }

struct Unit { int pm, pn; };
struct Gemm { const bf16_t* A; const bf16_t* Bt; int M, N, K; };

struct StaticOrder {
    int nM, nN, nwg, G, c;
    __host__ __device__ void init(int M, int N, int G_, int c_) { nM = M / BM; nN = N / BM; nwg = nM * nN; G = G_; c = c_; }
    __host__ __device__ bool next(int i, Unit& u) const {
        const long L = (long)i * G + c; if (L >= nwg) return false;
        int wgid = (int)L; { const int q = nwg / NXCD, r = nwg % NXCD, xcd = wgid % NXCD, off = wgid / NXCD; wgid = (xcd < r ? xcd * (q + 1) : r * (q + 1) + (xcd - r) * q) + off; }
        const int nig = WGM * nN, gid = wgid / nig, fm = gid * WGM, gsz = (nM - fm) < WGM ? (nM - fm) : WGM;
        u.pm = fm + ((wgid % nig) % gsz); u.pn = (wgid % nig) / gsz; return true;
    }
    __device__ __forceinline__ void a_ready(const Unit&) const {}
    __device__ __forceinline__ void done(const Unit&) const {}
};

__device__ __forceinline__ unsigned cvt_pk_bf16(float lo, float hi) { unsigned r; asm volatile("v_cvt_pk_bf16_f32 %0, %1, %2" : "=v"(r) : "v"(lo), "v"(hi)); return r; }
template <class Epi, class Sched, bool ALIGN_EPI = false, bool SP2 = false>
__device__ __forceinline__ void gemm_phase(PG8_LAS unsigned char* lds, const Gemm g, const Sched& S, const Epi& E) {
    const int tid = threadIdx.x, wid = __builtin_amdgcn_readfirstlane(tid >> 6), lane = tid & 63, wr = wid >> 2, wc = wid & 3, fr = lane & 15, fq = lane >> 4;
    const int K = g.K, nt = K / BK;
    unsigned voffA[2], voffB[2];
#pragma unroll
    for (int i = 0; i < 2; ++i) { int R, C; stage_rc(tid * 16 + i * 8192, R, C); const int Rb = Epi::PERM ? ((R & ~31) + perm32(R & 31)) : R;
        voffA[i] = (unsigned)(R * K + C) * 2u; voffB[i] = (unsigned)(Rb * K + C) * 2u; }
    const size_t kstep = (size_t)(BK * 2);
    const size_t hstep = (size_t)HALF * K * 2;
    const size_t tstep = 2 * hstep;
    const unsigned ldsw = (unsigned)wid * 1024u;
    const int aoff = lds_byte(wr * 64 + fr, fq * 8), boff = lds_byte(wc * 32 + fr, fq * 8);
#define PG8_SA(b, h) (((b) * 2 + (h)) * HTB)
#define PG8_SB(b, h) ((4 + (b) * 2 + (h)) * HTB)
#define PG8_STAGE(bufoff, gbase, voff) do { _Pragma("unroll") for (int _i = 0; _i < 2; ++_i) \
        __builtin_amdgcn_global_load_lds((const unsigned*)((const char*)(gbase) + (voff)[_i]), (PG8_LAS unsigned*)(lds + (bufoff) + ldsw + _i * 8192), 16, 0, 0); } while (0)
#define PG8_LDA(dst, b, h) do { _Pragma("unroll") for (int m = 0; m < 4; ++m) _Pragma("unroll") for (int k = 0; k < 2; ++k) dst[m][k] = *(const PG8_LAS bf16x8*)(lds + PG8_SA(b, h) + aoff + m * 2048 + k * 1024); } while (0)
#define PG8_LDB(dst, b, h) do { _Pragma("unroll") for (int n = 0; n < 2; ++n) _Pragma("unroll") for (int k = 0; k < 2; ++k) dst[n][k] = *(const PG8_LAS bf16x8*)(lds + PG8_SB(b, h) + boff + n * 2048 + k * 1024); } while (0)
#define PG8_MMA(ai, bj, At, Bt) do { __builtin_amdgcn_s_setprio(1); _Pragma("unroll") for (int m = 0; m < 4; ++m) _Pragma("unroll") for (int n = 0; n < 2; ++n) _Pragma("unroll") for (int k = 0; k < 2; ++k) \
        acc[ai][bj][m][n] = __builtin_amdgcn_mfma_f32_16x16x32_bf16(Bt[n][k], At[m][k], acc[ai][bj][m][n], 0, 0, 0); __builtin_amdgcn_s_setprio(0); } while (0)
#define PG8_WAIT_V(n) asm volatile("s_waitcnt vmcnt(" #n ")" ::: "memory")
#define PG8_WAIT_L(n) asm volatile("s_waitcnt lgkmcnt(" #n ")" ::: "memory")
#define PG8_BAR __builtin_amdgcn_s_barrier()
#define PG8_SCHED __builtin_amdgcn_sched_barrier(0)
    Unit cur, nxt; int ui = 0;
    if (!S.next(0, cur)) return;
    f32x4 acc[2][2][4][2];
#pragma unroll
    for (int a = 0; a < 2; ++a)
#pragma unroll
        for (int b = 0; b < 2; ++b)
#pragma unroll
            for (int m = 0; m < 4; ++m)
#pragma unroll
                for (int n = 0; n < 2; ++n) acc[a][b][m][n] = (f32x4){0.f, 0.f, 0.f, 0.f};
    bf16x8 At[4][2], B0[2][2], B1[2][2];
    const char* cA = (const char*)g.A + (size_t)cur.pm * tstep; const char* cB = (const char*)g.Bt + (size_t)cur.pn * tstep;
    S.a_ready(cur);
    if constexpr (SP2) {
        PG8_STAGE(PG8_SB(0, 0), cB, voffB); PG8_STAGE(PG8_SB(0, 1), cB + hstep, voffB); PG8_STAGE(PG8_SA(0, 0), cA, voffA); PG8_STAGE(PG8_SA(0, 1), cA + hstep, voffA);
        if (wr == 1) PG8_BAR;
        PG8_WAIT_V(2); PG8_BAR;
        PG8_STAGE(PG8_SB(1, 0), cB + kstep, voffB); PG8_STAGE(PG8_SA(1, 0), cA + kstep, voffA); PG8_STAGE(PG8_SB(1, 1), cB + hstep + kstep, voffB);
        PG8_WAIT_V(6); PG8_BAR;
    } else {
        PG8_STAGE(PG8_SB(0, 0), cB, voffB); PG8_STAGE(PG8_SA(0, 0), cA, voffA); PG8_STAGE(PG8_SB(0, 1), cB + hstep, voffB); PG8_STAGE(PG8_SA(0, 1), cA + hstep, voffA);
        if (wr == 1) PG8_BAR;
        PG8_WAIT_V(4); PG8_BAR;
        PG8_STAGE(PG8_SB(1, 0), cB + kstep, voffB); PG8_STAGE(PG8_SA(1, 0), cA + kstep, voffA); PG8_STAGE(PG8_SB(1, 1), cB + hstep + kstep, voffB);
        PG8_WAIT_V(6); PG8_BAR;
    }
    for (;;) {
        const bool has_next = S.next(ui + 1, nxt);
        const char* nA = has_next ? (const char*)g.A + (size_t)nxt.pm * tstep : cA; const char* nB = has_next ? (const char*)g.Bt + (size_t)nxt.pn * tstep : cB;
        for (int t = 0; t < nt; t += 2) {
            const bool last = (t == nt - 2);
            const char* a1 = cA + (size_t)(t + 1) * kstep;
            const char* a2 = last ? nA : cA + (size_t)(t + 2) * kstep; const char* b2 = last ? nB : cB + (size_t)(t + 2) * kstep;
            const char* a3 = a2 + kstep; const char* b3 = b2 + kstep;
            if (last && has_next) S.a_ready(nxt);
            if constexpr (SP2) {
            PG8_LDB(B0, 0, 0); PG8_LDB(B1, 0, 1); PG8_SCHED; PG8_LDA(At, 0, 0); PG8_STAGE(PG8_SA(1, 1), a1 + hstep, voffA);
            PG8_WAIT_V(8); PG8_WAIT_L(0); PG8_BAR; PG8_MMA(0, 0, At, B0); PG8_MMA(0, 1, At, B1); PG8_BAR; PG8_SCHED;
            PG8_LDA(At, 0, 1); PG8_STAGE(PG8_SB(0, 0), b2, voffB); PG8_STAGE(PG8_SB(0, 1), b2 + hstep, voffB); PG8_STAGE(PG8_SA(0, 0), a2, voffA);
            PG8_WAIT_V(8); PG8_WAIT_L(0); PG8_BAR; PG8_MMA(1, 0, At, B0); PG8_MMA(1, 1, At, B1); PG8_BAR; PG8_SCHED;
            PG8_LDB(B0, 1, 0); PG8_LDB(B1, 1, 1); PG8_SCHED; PG8_LDA(At, 1, 0); PG8_STAGE(PG8_SA(0, 1), a2 + hstep, voffA);
            PG8_WAIT_V(8); PG8_WAIT_L(0); PG8_BAR; PG8_MMA(0, 0, At, B0); PG8_MMA(0, 1, At, B1); PG8_BAR; PG8_SCHED;
            PG8_LDA(At, 1, 1); PG8_STAGE(PG8_SB(1, 0), b3, voffB); PG8_STAGE(PG8_SB(1, 1), b3 + hstep, voffB); PG8_STAGE(PG8_SA(1, 0), a3, voffA);
            PG8_WAIT_V(8); PG8_WAIT_L(0); PG8_BAR; PG8_MMA(1, 0, At, B0); PG8_MMA(1, 1, At, B1); PG8_BAR; PG8_SCHED;
            } else {
            PG8_LDB(B0, 0, 0); PG8_SCHED; PG8_LDA(At, 0, 0); PG8_STAGE(PG8_SA(1, 1), a1 + hstep, voffA);
            PG8_WAIT_L(8); PG8_BAR; PG8_WAIT_L(0); PG8_MMA(0, 0, At, B0); PG8_BAR; PG8_SCHED;
            PG8_LDB(B1, 0, 1); PG8_STAGE(PG8_SB(0, 0), b2, voffB);
            PG8_BAR; PG8_WAIT_L(0); PG8_MMA(0, 1, At, B1); PG8_BAR;
            PG8_LDA(At, 0, 1); PG8_STAGE(PG8_SA(0, 0), a2, voffA);
            PG8_BAR; PG8_WAIT_L(0); PG8_MMA(1, 0, At, B0); PG8_BAR; PG8_SCHED;
            PG8_STAGE(PG8_SB(0, 1), b2 + hstep, voffB);
            PG8_WAIT_V(6); PG8_BAR; PG8_MMA(1, 1, At, B1); PG8_BAR;
            PG8_LDB(B0, 1, 0); PG8_SCHED; PG8_LDA(At, 1, 0); PG8_STAGE(PG8_SA(0, 1), a2 + hstep, voffA);
            PG8_WAIT_L(8); PG8_BAR; PG8_WAIT_L(0); PG8_MMA(0, 0, At, B0); PG8_BAR; PG8_SCHED;
            PG8_LDB(B1, 1, 1); PG8_STAGE(PG8_SB(1, 0), b3, voffB);
            PG8_BAR; PG8_WAIT_L(0); PG8_MMA(0, 1, At, B1); PG8_BAR;
            PG8_LDA(At, 1, 1); PG8_STAGE(PG8_SA(1, 0), a3, voffA);
            PG8_BAR; PG8_WAIT_L(0); PG8_MMA(1, 0, At, B0); PG8_BAR; PG8_SCHED;
            PG8_STAGE(PG8_SB(1, 1), b3 + hstep, voffB);
            PG8_WAIT_V(6); PG8_BAR; PG8_MMA(1, 1, At, B1); PG8_BAR;
            }
        }
        if constexpr (ALIGN_EPI) { if (wr == 0) PG8_BAR; }
        if constexpr (!Epi::AFTER_DRAIN) { E(acc, cur, wr, wc, fr, fq); S.done(cur); }
        if (!has_next) break;
#pragma unroll
        for (int a = 0; a < 2; ++a)
#pragma unroll
            for (int b = 0; b < 2; ++b)
#pragma unroll
                for (int m = 0; m < 4; ++m)
#pragma unroll
                    for (int n = 0; n < 2; ++n) acc[a][b][m][n] = (f32x4){0.f, 0.f, 0.f, 0.f};
        cur = nxt; cA = nA; cB = nB; ++ui;
        if constexpr (ALIGN_EPI) { if (wr == 1) PG8_BAR; }
    }
    PG8_WAIT_V(0);
    if constexpr (!ALIGN_EPI) { if (wr == 0) PG8_BAR; }
    PG8_BAR;
    if constexpr (Epi::AFTER_DRAIN) { E.fused(acc, cur, wr, wc, fr, fq, lds, wid, lane); S.done(cur); }
#undef PG8_SA
#undef PG8_SB
#undef PG8_STAGE
#undef PG8_LDA
#undef PG8_LDB
#undef PG8_MMA
#undef PG8_WAIT_V
#undef PG8_WAIT_L
#undef PG8_BAR
#undef PG8_SCHED
}
}
#define LAS __attribute__((address_space(3)))
typedef unsigned short bf16_t;
typedef short bf16x8 __attribute__((ext_vector_type(8)));
typedef short s16x4 __attribute__((ext_vector_type(4)));
typedef float f32x4 __attribute__((ext_vector_type(4)));
typedef float f32x2 __attribute__((ext_vector_type(2)));
typedef float f32x16 __attribute__((ext_vector_type(16)));
typedef unsigned u32x4 __attribute__((ext_vector_type(4)));
typedef unsigned u32x2 __attribute__((ext_vector_type(2)));
typedef __bf16 bf16x2_t __attribute__((ext_vector_type(2)));

constexpr int NWAVES = 8, NTHR = 512;
constexpr int M_ = 32768, SEQ = 8192, DM = 1024, NIN = 4608, DFF = 4096, CCH = 512, PLED = 256, NHEAD = 4;
constexpr int ZQ = 1024, ZK = 1536, ZV = 2048, ZGC = 2560, ZGA = 3584;
constexpr float LOG2E = 1.4426950408889634f;
constexpr float QSCALE = 0.125f * LOG2E;
constexpr float ALPHA = 1.189207115002721f;
constexpr float EPS = 1e-5f;
constexpr float LAMBDA_INIT = 0.2f;
constexpr int LDS_BYTES = 147456;

constexpr size_t MiB = 1u << 20;
constexpr size_t WS_Z = 0;
constexpr size_t WS_WIN = 288 * MiB;
constexpr size_t WS_WFF1 = 297 * MiB;
constexpr size_t WS_WFF2 = 307 * MiB;
constexpr size_t WS_WO = 315 * MiB;
constexpr size_t WS_WC = 317 * MiB;
constexpr size_t WS_WA = 318 * MiB;
constexpr size_t WS_WPLE = 319 * MiB;
constexpr size_t WS_ST0 = 320 * MiB;
constexpr size_t WS_ST1 = 321 * MiB;
constexpr size_t WS_HB = 322 * MiB;
constexpr size_t WS_PE = 386 * MiB;
constexpr size_t WS_PB = 450 * MiB;
constexpr size_t WS_END = 466 * MiB;

__device__ __forceinline__ unsigned cvtpk(float lo, float hi) { f32x2 v = {lo, hi}; bf16x2_t b = __builtin_convertvector(v, bf16x2_t); return __builtin_bit_cast(unsigned, b); }
__device__ __forceinline__ float bflo(unsigned w) { return __uint_as_float(w << 16); }
__device__ __forceinline__ float bfhi(unsigned w) { return __uint_as_float(w & 0xffff0000u); }
__device__ __forceinline__ float sigm(float x) { return __builtin_amdgcn_rcpf(1.f + __builtin_amdgcn_exp2f(-x * LOG2E)); }
__device__ __forceinline__ float wave_sum(float v) {
#pragma unroll
    for (int o = 1; o < 64; o <<= 1) v += __shfl_xor(v, o);
    return v;
}
__device__ __forceinline__ void unpack8(const u32x4 w, f32x4& a, f32x4& b) {
    a = (f32x4){bflo(w.x), bfhi(w.x), bflo(w.y), bfhi(w.y)}; b = (f32x4){bflo(w.z), bfhi(w.z), bflo(w.w), bfhi(w.w)};
}
__device__ __forceinline__ u32x4 pack8(const f32x4 a, const f32x4 b) {
    u32x4 w; w.x = cvtpk(a[0], a[1]); w.y = cvtpk(a[2], a[3]); w.z = cvtpk(b[0], b[1]); w.w = cvtpk(b[2], b[3]); return w;
}

using pg8::Unit;
struct EpiZ {
    static constexpr bool PERM = true, AFTER_DRAIN = false;
    bf16_t* O; int ldc; int kind;
    __device__ __forceinline__ void operator()(const f32x4 (&acc)[2][2][4][2], const Unit& u, int wr, int wc, int fr, int fq) const {
        const int row0 = u.pm * 256 + wr * 64 + fr, col0 = u.pn * 256 + wc * 32 + 8 * fq;
        int mode = 0; if (kind == 0) mode = (u.pn == 4 || u.pn == 5) ? 1 : (u.pn >= 10 ? 2 : 0);
#pragma unroll
        for (int ai = 0; ai < 2; ++ai)
#pragma unroll
            for (int m = 0; m < 4; ++m) { bf16_t* rowp = O + (size_t)(row0 + ai * 128 + m * 16) * ldc + col0;
#pragma unroll
                for (int bj = 0; bj < 2; ++bj) { f32x4 v0 = acc[ai][bj][m][0], v1 = acc[ai][bj][m][1];
                    if (mode == 1) { v0 = v0 * QSCALE; v1 = v1 * QSCALE; }
                    else if (mode == 2) {
#pragma unroll
                        for (int e = 0; e < 4; ++e) { v0[e] = sigm(v0[e]); v1[e] = sigm(v1[e]); } }
                    *(u32x4*)(rowp + bj * 128) = pack8(v0, v1); } }
    }
};
struct EpiGate {
    static constexpr bool PERM = true, AFTER_DRAIN = false;
    bf16_t* MG; const bf16_t* Z; int gcol; int add;
    __device__ __forceinline__ void operator()(const f32x4 (&acc)[2][2][4][2], const Unit& u, int wr, int wc, int fr, int fq) const {
        const int row0 = u.pm * 256 + wr * 64 + fr, col0 = u.pn * 256 + wc * 32 + 8 * fq;
#pragma unroll
        for (int ai = 0; ai < 2; ++ai)
#pragma unroll
            for (int m = 0; m < 4; ++m) { const size_t row = (size_t)(row0 + ai * 128 + m * 16);
#pragma unroll
                for (int bj = 0; bj < 2; ++bj) { const int col = col0 + bj * 128;
                    const u32x4 gw = *(const u32x4*)(Z + row * NIN + gcol + col); f32x4 g0, g1; unpack8(gw, g0, g1);
                    f32x4 v0 = acc[ai][bj][m][0] * g0, v1 = acc[ai][bj][m][1] * g1;
                    bf16_t* dst = MG + row * DM + col;
                    if (add) { const u32x4 pw = *(const u32x4*)dst; f32x4 p0, p1; unpack8(pw, p0, p1); v0 = v0 + p0; v1 = v1 + p1; }
                    *(u32x4*)dst = pack8(v0, v1); } }
    }
};
struct EpiRes {
    static constexpr bool PERM = false, AFTER_DRAIN = false;
    const float* src; const float* st; const float* g; const float* b; const bf16_t* ple; float* out;
    __device__ __forceinline__ void operator()(const f32x4 (&acc)[2][2][4][2], const Unit& u, int wr, int wc, int fr, int fq) const {
        const int row0 = u.pm * 256 + wr * 64 + fr, col0 = u.pn * 256 + wc * 32 + 4 * fq;
#pragma unroll
        for (int ai = 0; ai < 2; ++ai)
#pragma unroll
            for (int m = 0; m < 4; ++m) { const size_t row = (size_t)(row0 + ai * 128 + m * 16); const f32x2 s = *(const f32x2*)(st + row * 2);
#pragma unroll
                for (int bj = 0; bj < 2; ++bj)
#pragma unroll
                    for (int n = 0; n < 2; ++n) { const int col = col0 + bj * 128 + n * 16;
                        const f32x4 xv = *(const f32x4*)(src + row * DM + col); const f32x4 gv = *(const f32x4*)(g + col), bv = *(const f32x4*)(b + col);
                        f32x4 o = ((xv - s.x) * s.y * gv + bv) * ALPHA + acc[ai][bj][m][n];
                        if (ple) { const u32x2 pw = *(const u32x2*)(ple + row * DM + col); o = o + (f32x4){bflo(pw.x), bfhi(pw.x), bflo(pw.y), bfhi(pw.y)}; }
                        *(f32x4*)(out + row * DM + col) = o; }
                asm volatile("" ::: "memory"); }
    }
};
struct EpiFF1 {
    static constexpr bool PERM = true, AFTER_DRAIN = false;
    bf16_t* FF1; bf16_t* PE;
    __device__ __forceinline__ void operator()(const f32x4 (&acc)[2][2][4][2], const Unit& u, int wr, int wc, int fr, int fq) const {
        const int row0 = u.pm * 256 + wr * 64 + fr;
        if (u.pn < 16) {
            const int col0 = u.pn * 256 + wc * 32 + 8 * fq;
#pragma unroll
            for (int ai = 0; ai < 2; ++ai)
#pragma unroll
                for (int m = 0; m < 4; ++m) { bf16_t* rowp = FF1 + (size_t)(row0 + ai * 128 + m * 16) * DFF + col0;
#pragma unroll
                    for (int bj = 0; bj < 2; ++bj) { f32x4 v0 = acc[ai][bj][m][0], v1 = acc[ai][bj][m][1];
#pragma unroll
                        for (int e = 0; e < 4; ++e) { const float a = fmaxf(v0[e], 0.f), c = fmaxf(v1[e], 0.f); v0[e] = a * a; v1[e] = c * c; }
                        *(u32x4*)(rowp + bj * 128) = pack8(v0, v1); } }
        } else {
            const int col0 = (u.pn - 16) * 256 + wc * 32 + 8 * fq;
#pragma unroll
            for (int ai = 0; ai < 2; ++ai)
#pragma unroll
                for (int m = 0; m < 4; ++m) { bf16_t* rowp = PE + (size_t)(row0 + ai * 128 + m * 16) * DM + col0;
#pragma unroll
                    for (int bj = 0; bj < 2; ++bj) { f32x4 v0 = acc[ai][bj][m][0], v1 = acc[ai][bj][m][1];
                        const u32x4 pw = *(const u32x4*)(rowp + bj * 128); f32x4 p0, p1; unpack8(pw, p0, p1);
#pragma unroll
                        for (int e = 0; e < 4; ++e) { v0[e] = sigm(v0[e]) * p0[e]; v1[e] = sigm(v1[e]) * p1[e]; }
                        *(u32x4*)(rowp + bj * 128) = pack8(v0, v1); } }
        }
    }
};

__device__ __forceinline__ unsigned f2bf(float f) { unsigned u = __float_as_uint(f); return (u + 0x7fffu + ((u >> 16) & 1u)) >> 16; }
__device__ __forceinline__ unsigned pk2(float lo, float hi) { return f2bf(lo) | (f2bf(hi) << 16); }
__device__ __forceinline__ void transpose_item(const float* W, int K, int N, bf16_t* WT, int row_off, LAS float* scr, int item, int lane) {
    const int nblk = N / 32, kb = item / nblk, nb = item % nblk, k0 = 64 * kb, n0 = 32 * nb;
#pragma unroll 8
    for (int i = 0; i < 32; ++i) { const int kk = 2 * i + (lane >> 5); scr[kk * 33 + (lane & 31)] = W[(size_t)(k0 + kk) * N + n0 + (lane & 31)]; }
    asm volatile("s_waitcnt lgkmcnt(0)" ::: "memory");
    const int c = lane & 7;
#pragma unroll
    for (int j = 0; j < 4; ++j) { const int n = (lane >> 3) + 8 * j; const LAS float* s = scr + (8 * c) * 33 + n;
        u32x4 o; o.x = pk2(s[0 * 33], s[1 * 33]); o.y = pk2(s[2 * 33], s[3 * 33]); o.z = pk2(s[4 * 33], s[5 * 33]); o.w = pk2(s[6 * 33], s[7 * 33]);
        *(u32x4*)(WT + (size_t)(row_off + n0 + n) * K + k0 + 8 * c) = o; }
    asm volatile("s_waitcnt lgkmcnt(0)" ::: "memory");
}
template <int MODE> __device__ __forceinline__ void ln_rows(const float* src, bf16_t* dstb, float* dstf, float* st, const float* g, const float* b, int gw, int ngw, int lane) {
    f32x4 gv[4], bv[4];
#pragma unroll
    for (int j = 0; j < 4; ++j) { gv[j] = *((const f32x4*)g + lane + 64 * j); bv[j] = *((const f32x4*)b + lane + 64 * j); }
    for (int row = gw; row < M_; row += ngw) {
        const f32x4* xr = (const f32x4*)(src + (size_t)row * DM) + lane;
        f32x4 v[4]; float s = 0.f;
#pragma unroll
        for (int j = 0; j < 4; ++j) { v[j] = xr[64 * j]; s += (v[j][0] + v[j][1]) + (v[j][2] + v[j][3]); }
        const float mean = wave_sum(s) * (1.f / DM); float s2 = 0.f;
#pragma unroll
        for (int j = 0; j < 4; ++j) { v[j] = v[j] - mean; s2 += (v[j][0] * v[j][0] + v[j][1] * v[j][1]) + (v[j][2] * v[j][2] + v[j][3] * v[j][3]); }
        const float rstd = 1.f / sqrtf(wave_sum(s2) * (1.f / DM) + EPS);
        if (MODE == 0) {
            u32x2* o8 = (u32x2*)(dstb + (size_t)row * DM) + lane;
#pragma unroll
            for (int j = 0; j < 4; ++j) { const f32x4 y = v[j] * rstd * gv[j] + bv[j]; u32x2 w; w.x = cvtpk(y[0], y[1]); w.y = cvtpk(y[2], y[3]); o8[64 * j] = w; }
            if (lane == 0) *(f32x2*)(st + (size_t)row * 2) = (f32x2){mean, rstd};
        } else {
            f32x4* o = (f32x4*)(dstf + (size_t)row * DM) + lane;
#pragma unroll
            for (int j = 0; j < 4; ++j) o[64 * j] = v[j] * rstd * gv[j] + bv[j];
        }
    }
}

__device__ __forceinline__ void conv_unit(LAS unsigned char* lds, const bf16_t* Z, bf16_t* UC, const float* cw, const float* lg, const float* lb, int unit) {
    const int tid = threadIdx.x, lane = tid & 63, wid = tid >> 6;
    const int m0 = unit * 32, s0 = m0 % SEQ;
    float w[31];
#pragma unroll
    for (int k = 0; k < 31; ++k) w[k] = cw[k * CCH + tid];
    float uw[62];
#pragma unroll
    for (int i = 0; i < 62; ++i) {
        float v = 0.f;
        if (s0 - 30 + i >= 0) { const bf16_t* zp = Z + (size_t)(m0 - 30 + i) * NIN + tid; const float a = __uint_as_float((unsigned)zp[0] << 16), gg = __uint_as_float((unsigned)zp[CCH] << 16); v = a * sigm(gg); }
        uw[i] = v;
    }
    LAS float* yl = (LAS float*)lds;
#pragma unroll
    for (int j = 0; j < 32; ++j) { float y = 0.f;
#pragma unroll
        for (int k = 0; k < 31; ++k) y += w[k] * uw[j + k];
        yl[j * CCH + tid] = y; }
    __syncthreads();
#pragma unroll
    for (int rr = 0; rr < 4; ++rr) { const int row = wid * 4 + rr;
        f32x4 v[2]; float s = 0.f;
#pragma unroll
        for (int i = 0; i < 2; ++i) { v[i] = *(const LAS f32x4*)(yl + row * CCH + lane * 4 + 256 * i); s += (v[i][0] + v[i][1]) + (v[i][2] + v[i][3]); }
        const float mean = wave_sum(s) * (1.f / CCH); float s2 = 0.f;
#pragma unroll
        for (int i = 0; i < 2; ++i) { v[i] = v[i] - mean; s2 += (v[i][0] * v[i][0] + v[i][1] * v[i][1]) + (v[i][2] * v[i][2] + v[i][3] * v[i][3]); }
        const float rstd = 1.f / sqrtf(wave_sum(s2) * (1.f / CCH) + EPS);
#pragma unroll
        for (int i = 0; i < 2; ++i) { const int col = lane * 4 + 256 * i; const f32x4 gv = *(const f32x4*)(lg + col), bv = *(const f32x4*)(lb + col);
            f32x4 y = v[i] * rstd * gv + bv;
#pragma unroll
            for (int e = 0; e < 4; ++e) y[e] = y[e] * sigm(y[e]);
            u32x2 o; o.x = cvtpk(y[0], y[1]); o.y = cvtpk(y[2], y[3]); *(u32x2*)(UC + (size_t)(m0 + row) * CCH + col) = o; }
    }
    __syncthreads();
}

constexpr int A_KSTR = 144, A_VSTR = 320, A_KB = 64 * A_KSTR, A_VB = 64 * A_VSTR, A_BUF = 2 * A_KB + A_VB, A_SCR = 2 * A_BUF;
__device__ __forceinline__ int crow(int r, int hi) { return (r & 3) + 8 * (r >> 2) + 4 * hi; }
__device__ __forceinline__ s16x4 vtr(const LAS unsigned char* p) { return __builtin_bit_cast(s16x4, __builtin_amdgcn_ds_read_tr16_b64_v4i16((LAS s16x4*)p)); }

__device__ __forceinline__ void attn_unit(LAS unsigned char* lds, const bf16_t* Z, bf16_t* OA, const float* subg, int b, int h, int qb, float lam) {
    const int tid = threadIdx.x, lane = tid & 63, r32 = lane & 31, hi = lane >> 5;
    const int wid = __builtin_amdgcn_readfirstlane(tid >> 6), rg = wid >> 1, c = wid & 1;
    const size_t brow0 = (size_t)b * SEQ;
    const int q0 = qb * 128, qpos = q0 + 32 * rg + r32;
    const float slope2 = __builtin_amdgcn_exp2f(-2.f * (float)(h + 1)) * LOG2E;
    bf16x8 qf[4];
    { const bf16_t* qp = Z + (brow0 + qpos) * NIN + ZQ + h * 128 + c * 64 + hi * 8;
#pragma unroll
      for (int s = 0; s < 4; ++s) qf[s] = *(const bf16x8*)(qp + 16 * s); }
    float kc[16];
#pragma unroll
    for (int r = 0; r < 16; ++r) kc[r] = slope2 * (float)crow(r, hi);
    const int skey = tid >> 4, sch = tid & 15;
    const bf16_t* gsrc = Z + (brow0 + skey) * NIN + h * 128 + sch * 8;
    const int kdst = (sch >> 3) * A_KB + skey * A_KSTR + (sch & 7) * 16, vdst = 2 * A_KB + skey * A_VSTR + sch * 16;
    u32x4 stg[4];
#define A_GLOAD(t) do { const bf16_t* p_ = gsrc + (size_t)(64 * (t)) * NIN; stg[0] = *(const u32x4*)(p_ + ZK); stg[1] = *(const u32x4*)(p_ + ZK + 32 * NIN); \
        stg[2] = *(const u32x4*)(p_ + ZV); stg[3] = *(const u32x4*)(p_ + ZV + 32 * NIN); } while (0)
#define A_LWRITE(bufo) do { LAS unsigned char* d_ = lds + (bufo); *(LAS u32x4*)(d_ + kdst) = stg[0]; *(LAS u32x4*)(d_ + kdst + 32 * A_KSTR) = stg[1]; \
        *(LAS u32x4*)(d_ + vdst) = stg[2]; *(LAS u32x4*)(d_ + vdst + 32 * A_VSTR) = stg[3]; } while (0)
    const int nt = 2 * (qb + 1);
    LAS float* wscr = (LAS float*)(lds + A_SCR) + wid * 32;
    const int koff = c * A_KB + r32 * A_KSTR + hi * 16;
    const int voff = 2 * A_KB + (4 * hi + ((lane & 15) >> 2)) * A_VSTR + (16 * ((lane >> 4) & 1) + 4 * (lane & 3)) * 2;
    f32x16 O[4];
#pragma unroll
    for (int d = 0; d < 4; ++d)
#pragma unroll
        for (int r = 0; r < 16; ++r) O[d][r] = 0.f;
    float mrun = -1e30f, lrun = 0.f;
    A_GLOAD(nt - 1); A_LWRITE(0); __syncthreads();
    int bufo = 0;
    for (int t = nt - 1; t >= 0; --t) {
        if (t > 0) A_GLOAD(t - 1);
        const bool skip = (64 * t > q0 + 32 * rg + 31);
        if (!skip) {
            const LAS unsigned char* Kb = lds + bufo + koff;
            const LAS unsigned char* Vb = lds + bufo + voff;
            const float base = slope2 * (float)(64 * t - qpos);
            f32x16 S0, S1;
#pragma unroll
            for (int r = 0; r < 16; ++r) { S0[r] = base + kc[r]; S1[r] = base + 32.f * slope2 + kc[r]; }
#pragma unroll
            for (int s = 0; s < 4; ++s) {
                const bf16x8 k0 = *(const LAS bf16x8*)(Kb + s * 32), k1 = *(const LAS bf16x8*)(Kb + 32 * A_KSTR + s * 32);
                S0 = __builtin_amdgcn_mfma_f32_32x32x16_bf16(k0, qf[s], S0, 0, 0, 0);
                S1 = __builtin_amdgcn_mfma_f32_32x32x16_bf16(k1, qf[s], S1, 0, 0, 0);
            }
            if (t >= nt - 2) { const int kb = 64 * (t - (nt - 2)), qrel = 32 * rg + r32;
#pragma unroll
                for (int r = 0; r < 16; ++r) { const int kr = kb + crow(r, hi); if (kr > qrel) S0[r] = -1e30f; if (kr + 32 > qrel) S1[r] = -1e30f; } }
            float rm = fmaxf(S0[0], S1[0]);
#pragma unroll
            for (int r = 1; r < 16; ++r) rm = fmaxf(rm, fmaxf(S0[r], S1[r]));
            rm = fmaxf(rm, __shfl_xor(rm, 32));
            const bool need = rm > mrun + 8.f;
            if (__any(need)) {
                const float mn = need ? rm : mrun; const float al = __builtin_amdgcn_exp2f(mrun - mn);
                lrun *= al; mrun = mn;
                if (hi == 0) wscr[r32] = al;
#pragma unroll
                for (int r = 0; r < 16; ++r) { const float a = wscr[crow(r, hi)];
#pragma unroll
                    for (int d = 0; d < 4; ++d) O[d][r] *= a; }
            }
            float ls = 0.f;
#pragma unroll
            for (int r = 0; r < 16; ++r) { S0[r] = __builtin_amdgcn_exp2f(S0[r] - mrun); S1[r] = __builtin_amdgcn_exp2f(S1[r] - mrun); ls += S0[r] + S1[r]; }
            lrun += ls;
            bf16x8 pa[4];
            { u32x4 w;
              w.x = cvtpk(S0[0], S0[1]); w.y = cvtpk(S0[2], S0[3]); w.z = cvtpk(S0[4], S0[5]); w.w = cvtpk(S0[6], S0[7]); pa[0] = __builtin_bit_cast(bf16x8, w);
              w.x = cvtpk(S0[8], S0[9]); w.y = cvtpk(S0[10], S0[11]); w.z = cvtpk(S0[12], S0[13]); w.w = cvtpk(S0[14], S0[15]); pa[1] = __builtin_bit_cast(bf16x8, w);
              w.x = cvtpk(S1[0], S1[1]); w.y = cvtpk(S1[2], S1[3]); w.z = cvtpk(S1[4], S1[5]); w.w = cvtpk(S1[6], S1[7]); pa[2] = __builtin_bit_cast(bf16x8, w);
              w.x = cvtpk(S1[8], S1[9]); w.y = cvtpk(S1[10], S1[11]); w.z = cvtpk(S1[12], S1[13]); w.w = cvtpk(S1[14], S1[15]); pa[3] = __builtin_bit_cast(bf16x8, w); }
#pragma unroll
            for (int d = 0; d < 4; ++d)
#pragma unroll
                for (int ks = 0; ks < 4; ++ks) {
                    const s16x4 lo = vtr(Vb + (16 * ks) * A_VSTR + d * 64), hh = vtr(Vb + (16 * ks + 8) * A_VSTR + d * 64);
                    const bf16x8 vf = __builtin_shufflevector(lo, hh, 0, 1, 2, 3, 4, 5, 6, 7);
                    O[d] = __builtin_amdgcn_mfma_f32_32x32x16_bf16(pa[ks], vf, O[d], 0, 0, 0);
                }
        }
        if (t > 0) A_LWRITE(bufo ^ A_BUF);
        __syncthreads();
        bufo ^= A_BUF;
    }
#undef A_GLOAD
#undef A_LWRITE
    lrun += __shfl_xor(lrun, 32);
    { const float f = (c == 0 ? 1.f : -lam) / lrun;
      if (hi == 0) wscr[r32] = f;
#pragma unroll
      for (int r = 0; r < 16; ++r) { const float a = wscr[crow(r, hi)];
#pragma unroll
          for (int d = 0; d < 4; ++d) O[d][r] *= a; } }
    LAS float* xch = (LAS float*)lds + rg * 4096;
    if (c == 1) {
#pragma unroll
        for (int d = 0; d < 4; ++d)
#pragma unroll
            for (int r = 0; r < 16; ++r) xch[(d * 16 + r) * 64 + lane] = O[d][r];
    }
    __syncthreads();
    if (c == 0) {
        float ssq[16];
#pragma unroll
        for (int r = 0; r < 16; ++r) { float s = 0.f;
#pragma unroll
            for (int d = 0; d < 4; ++d) { O[d][r] += xch[(d * 16 + r) * 64 + lane]; s += O[d][r] * O[d][r]; }
            ssq[r] = s; }
#pragma unroll
        for (int o = 1; o < 32; o <<= 1)
#pragma unroll
            for (int r = 0; r < 16; ++r) ssq[r] += __shfl_xor(ssq[r], o);
        float gsc[4];
#pragma unroll
        for (int d = 0; d < 4; ++d) gsc[d] = subg[h * 128 + 32 * d + r32] * (1.f - LAMBDA_INIT);
        bf16_t* op = OA + (brow0 + q0 + 32 * rg) * CCH + h * 128 + r32;
#pragma unroll
        for (int r = 0; r < 16; ++r) { const float rs = 1.f / sqrtf(ssq[r] * (1.f / 128.f) + EPS);
#pragma unroll
            for (int d = 0; d < 4; ++d) op[(size_t)crow(r, hi) * CCH + 32 * d] = (bf16_t)f2bf(O[d][r] * rs * gsc[d]); }
    }
    __syncthreads();
}

struct Args {
    const float *x, *p, *ln0g, *ln0b, *w_in, *conv_w, *cln_g, *cln_b, *w_conv_out, *lq1, *lk1, *lq2, *lk2, *subg, *w_attn_out, *w_o,
                *ln1g, *ln1b, *w_ff1, *w_ff2, *w_ple, *w_pg, *ln2g, *ln2b;
    float* out; unsigned char* ws; int ph_lo, ph_hi;
};
constexpr int NPHASE = 9;

__global__ void __launch_bounds__(NTHR, 2) fwd_kernel(Args a) {
    extern __shared__ __attribute__((aligned(16))) unsigned char lds_raw[];
    LAS unsigned char* lds = (LAS unsigned char*)lds_raw;
    const int tid = threadIdx.x, lane = tid & 63, wid = __builtin_amdgcn_readfirstlane(tid >> 6);
    const int G = gridDim.x, bx = blockIdx.x;
    const int vcu = (G % 8 == 0) ? (bx % 8) * (G / 8) + bx / 8 : bx;
    const int gw = vcu * NWAVES + wid, ngw = G * NWAVES;
    unsigned char* ws = a.ws;
    bf16_t* Zb = (bf16_t*)(ws + WS_Z); bf16_t* FF1 = (bf16_t*)(ws + WS_Z);
    bf16_t *WIN = (bf16_t*)(ws + WS_WIN), *WFF1 = (bf16_t*)(ws + WS_WFF1), *WFF2 = (bf16_t*)(ws + WS_WFF2), *WO = (bf16_t*)(ws + WS_WO),
           *WC = (bf16_t*)(ws + WS_WC), *WA = (bf16_t*)(ws + WS_WA), *WPLE = (bf16_t*)(ws + WS_WPLE);
    float *ST0 = (float*)(ws + WS_ST0), *ST1 = (float*)(ws + WS_ST1);
    bf16_t *HB = (bf16_t*)(ws + WS_HB), *PE = (bf16_t*)(ws + WS_PE), *PB = (bf16_t*)(ws + WS_PB);
    bf16_t *UC = (bf16_t*)a.out, *OA = (bf16_t*)a.out + (size_t)M_ * CCH;
    const int lo = a.ph_lo, hi = a.ph_hi;
    cg::grid_group grid = cg::this_grid();
#define IN(k) (lo <= (k) && (k) < hi)
#define SEAM(k) do { if (IN(k) && IN((k) + 1)) grid.sync(); } while (0)

    if (IN(0)) {
        LAS float* scr = (LAS float*)(lds + wid * 16384);
        constexpr int I_IN = 16 * 144, I_C = 8 * 32, I_A = 8 * 32, I_O = 16 * 32, I_F1 = 16 * 128, I_PG = 16 * 32, I_F2 = 64 * 32, I_PL = 4 * 32;
        constexpr int NIT = I_IN + I_C + I_A + I_O + I_F1 + I_PG + I_F2 + I_PL;
        for (int it = gw; it < NIT; it += ngw) {
            int r = it;
            if (r < I_IN) { transpose_item(a.w_in, DM, NIN, WIN, 0, scr, r, lane); continue; } r -= I_IN;
            if (r < I_C) { transpose_item(a.w_conv_out, CCH, DM, WC, 0, scr, r, lane); continue; } r -= I_C;
            if (r < I_A) { transpose_item(a.w_attn_out, CCH, DM, WA, 0, scr, r, lane); continue; } r -= I_A;
            if (r < I_O) { transpose_item(a.w_o, DM, DM, WO, 0, scr, r, lane); continue; } r -= I_O;
            if (r < I_F1) { transpose_item(a.w_ff1, DM, DFF, WFF1, 0, scr, r, lane); continue; } r -= I_F1;
            if (r < I_PG) { transpose_item(a.w_pg, DM, DM, WFF1, DFF, scr, r, lane); continue; } r -= I_PG;
            if (r < I_F2) { transpose_item(a.w_ff2, DFF, DM, WFF2, 0, scr, r, lane); continue; } r -= I_F2;
            transpose_item(a.w_ple, PLED, DM, WPLE, 0, scr, r, lane);
        }
        ln_rows<0>(a.x, HB, nullptr, ST0, a.ln0g, a.ln0b, gw, ngw, lane);
        for (size_t i = (size_t)(vcu * NTHR + tid); i < (size_t)M_ * PLED / 8; i += (size_t)G * NTHR) {
            const f32x4 v0 = *((const f32x4*)a.p + 2 * i), v1 = *((const f32x4*)a.p + 2 * i + 1);
            *((u32x4*)PB + i) = pack8(v0, v1);
        }
    }
    SEAM(0);
    if (IN(1)) {
        { pg8::Gemm g{HB, WIN, M_, NIN, DM}; pg8::StaticOrder S; S.init(M_, NIN, G, bx); EpiZ E{Zb, NIN, 0};
          pg8::gemm_phase<EpiZ, pg8::StaticOrder, true, true>(lds, g, S, E); }
        { pg8::Gemm g{PB, WPLE, M_, DM, PLED}; pg8::StaticOrder S; S.init(M_, DM, G, bx); EpiZ E{PE, DM, 1};
          pg8::gemm_phase<EpiZ, pg8::StaticOrder, true, true>(lds, g, S, E); }
    }
    SEAM(1);
    if (IN(2)) {
        float lam;
        { const float a1 = wave_sum(a.lq1[lane] * a.lk1[lane]), a2 = wave_sum(a.lq2[lane] * a.lk2[lane]); lam = expf(a1) - expf(a2) + LAMBDA_INIT; }
        for (int u = vcu; u < 1024; u += G) {
            const int i = u >> 8, v = u & 255, bh = v >> 4, s = v & 15;
            const int qb = (i == 0) ? 63 - s : (i == 1) ? 32 + s : (i == 2) ? 31 - s : s;
            attn_unit(lds, Zb, OA, a.subg, bh >> 2, bh & 3, qb, lam);
        }
        for (int u = vcu; u < M_ / 32; u += G) conv_unit(lds, Zb, UC, a.conv_w, a.cln_g, a.cln_b, u);
    }
    SEAM(2);
    if (IN(3)) {
        { pg8::Gemm g{UC, WC, M_, DM, CCH}; pg8::StaticOrder S; S.init(M_, DM, G, bx); EpiGate E{HB, Zb, ZGC, 0};
          pg8::gemm_phase<EpiGate, pg8::StaticOrder, true, true>(lds, g, S, E); }
        { pg8::Gemm g{OA, WA, M_, DM, CCH}; pg8::StaticOrder S; S.init(M_, DM, G, bx); EpiGate E{HB, Zb, ZGA, 1};
          pg8::gemm_phase<EpiGate, pg8::StaticOrder, true, true>(lds, g, S, E); }
    }
    SEAM(3);
    if (IN(4)) {
        pg8::Gemm g{HB, WO, M_, DM, DM}; pg8::StaticOrder S; S.init(M_, DM, G, bx); EpiRes E{a.x, ST0, a.ln0g, a.ln0b, nullptr, a.out};
        pg8::gemm_phase<EpiRes, pg8::StaticOrder, true, true>(lds, g, S, E);
    }
    SEAM(4);
    if (IN(5)) ln_rows<0>(a.out, HB, nullptr, ST1, a.ln1g, a.ln1b, gw, ngw, lane);
    SEAM(5);
    if (IN(6)) {
        pg8::Gemm g{HB, WFF1, M_, DFF + DM, DM}; pg8::StaticOrder S; S.init(M_, DFF + DM, G, bx); EpiFF1 E{FF1, PE};
        pg8::gemm_phase<EpiFF1, pg8::StaticOrder, true, true>(lds, g, S, E);
    }
    SEAM(6);
    if (IN(7)) {
        pg8::Gemm g{FF1, WFF2, M_, DM, DFF}; pg8::StaticOrder S; S.init(M_, DM, G, bx); EpiRes E{a.out, ST1, a.ln1g, a.ln1b, PE, a.out};
        pg8::gemm_phase<EpiRes, pg8::StaticOrder, true, true>(lds, g, S, E);
    }
    SEAM(7);
    if (IN(8)) ln_rows<1>(a.out, nullptr, a.out, nullptr, a.ln2g, a.ln2b, gw, ngw, lane);
#undef IN
#undef SEAM
}

#ifndef N_LAUNCH_MODE
#define N_LAUNCH_MODE 0
#endif
extern "C" void kernel_launch(void* const* d_in, const int* in_sizes, int n_in, void* d_out, int out_size, void* d_ws, size_t ws_size, hipStream_t stream) {
    static int grid = 0;
    if (grid == 0) {
        int dev = 0, cus = 0, per_cu = 0;
        if (n_in != 24 || out_size != M_ * DM || ws_size < WS_END) { fprintf(stderr, "kernel_launch: unexpected shapes (n_in %d out %d ws %zu)\n", n_in, out_size, ws_size); grid = -1; return; }
        (void)hipGetDevice(&dev); (void)hipDeviceGetAttribute(&cus, hipDeviceAttributeMultiprocessorCount, dev);
        if (hipFuncSetAttribute((const void*)fwd_kernel, hipFuncAttributeMaxDynamicSharedMemorySize, LDS_BYTES) != hipSuccess) { fprintf(stderr, "kernel_launch: hipFuncSetAttribute failed\n"); grid = -1; return; }
        if (hipOccupancyMaxActiveBlocksPerMultiprocessor(&per_cu, (const void*)fwd_kernel, NTHR, LDS_BYTES) != hipSuccess || per_cu < 1) { fprintf(stderr, "kernel_launch: occupancy query says %d\n", per_cu); per_cu = 1; }
        (void)hipGetLastError();
        grid = cus * 1;
        if (per_cu < 1) grid = cus;
    }
    if (grid < 0) return;
    Args a{};
    const float** f = (const float**)&a;
    for (int i = 0; i < 24; ++i) f[i] = (const float*)d_in[i];
    a.out = (float*)d_out; a.ws = (unsigned char*)d_ws;
#if N_LAUNCH_MODE == 0
    a.ph_lo = 0; a.ph_hi = NPHASE;
    void* args[] = {&a};
    hipError_t e = hipLaunchCooperativeKernel((const void*)fwd_kernel, dim3(grid), dim3(NTHR), args, LDS_BYTES, stream);
    if (e != hipSuccess) fprintf(stderr, "cooperative launch failed: %s (grid %d)\n", hipGetErrorString(e), grid);
#else
    for (int ph = 0; ph < NPHASE; ++ph) { a.ph_lo = ph; a.ph_hi = ph + 1; hipLaunchKernelGGL(fwd_kernel, dim3(grid), dim3(NTHR), LDS_BYTES, stream, a); }
#endif
}
```

```cpp
#include <hip/hip_runtime.h>
#include <hip/hip_cooperative_groups.h>
#include <cstdio>
#include <cstdint>
namespace cg = cooperative_groups;
namespace pg8 {
#define PG8_LAS __attribute__((address_space(3)))
typedef unsigned short bf16_t;
typedef short bf16x8 __attribute__((ext_vector_type(8)));
typedef float f32x4 __attribute__((ext_vector_type(4)));
typedef unsigned u32x4 __attribute__((ext_vector_type(4)));
constexpr int BM = 256, BK = 64, HALF = 128, HTB = HALF * BK * 2  , STAGE_BYTES = 8 * HTB, NXCD = 8, WGM = 8;

__host__ __device__ __forceinline__ int lds_byte(int r, int c) { const int st = (r >> 4) * 2 + (c >> 5), rr = r & 15, cc = c & 31, ob = rr * 64 + cc * 2; return st * 1024 + (ob ^ (((ob >> 9) & 1) << 5)); }
__host__ __device__ __forceinline__ void stage_rc(int b, int& R, int& C) { const int st = b / 1024, sb = b % 1024, swz = sb ^ (((sb >> 9) & 1) << 5); R = (st >> 1) * 16 + swz / 64; C = (st & 1) * 32 + (swz % 64) / 2; }
__host__ __device__ __forceinline__ int perm32(int rho) { const int n = rho >> 4, i = rho & 15; return 8 * (i >> 2) + 4 * n + (i & 3); }

struct Unit { int pm, pn; };
struct Gemm { const bf16_t* A; const bf16_t* Bt; int M, N, K; };

struct StaticOrder {
    int nM, nN, nwg, G, c;
    __host__ __device__ void init(int M, int N, int G_, int c_) { nM = M / BM; nN = N / BM; nwg = nM * nN; G = G_; c = c_; }
    __host__ __device__ bool next(int i, Unit& u) const {
        const long L = (long)i * G + c; if (L >= nwg) return false;
        int wgid = (int)L; { const int q = nwg / NXCD, r = nwg % NXCD, xcd = wgid % NXCD, off = wgid / NXCD; wgid = (xcd < r ? xcd * (q + 1) : r * (q + 1) + (xcd - r) * q) + off; }
        const int nig = WGM * nN, gid = wgid / nig, fm = gid * WGM, gsz = (nM - fm) < WGM ? (nM - fm) : WGM;
        u.pm = fm + ((wgid % nig) % gsz); u.pn = (wgid % nig) / gsz; return true;
    }
    __device__ __forceinline__ void a_ready(const Unit&) const {}
    __device__ __forceinline__ void done(const Unit&) const {}
};

__device__ __forceinline__ unsigned cvt_pk_bf16(float lo, float hi) { unsigned r; asm volatile("v_cvt_pk_bf16_f32 %0, %1, %2" : "=v"(r) : "v"(lo), "v"(hi)); return r; }
template <class Epi, class Sched, bool ALIGN_EPI = false, bool SP2 = false>
__device__ __forceinline__ void gemm_phase(PG8_LAS unsigned char* lds, const Gemm g, const Sched& S, const Epi& E) {
    const int tid = threadIdx.x, wid = __builtin_amdgcn_readfirstlane(tid >> 6), lane = tid & 63, wr = wid >> 2, wc = wid & 3, fr = lane & 15, fq = lane >> 4;
    const int K = g.K, nt = K / BK;
    unsigned voffA[2], voffB[2];
#pragma unroll
    for (int i = 0; i < 2; ++i) { int R, C; stage_rc(tid * 16 + i * 8192, R, C); const int Rb = Epi::PERM ? ((R & ~31) + perm32(R & 31)) : R;
        voffA[i] = (unsigned)(R * K + C) * 2u; voffB[i] = (unsigned)(Rb * K + C) * 2u; }
    const size_t kstep = (size_t)(BK * 2);
    const size_t hstep = (size_t)HALF * K * 2;
    const size_t tstep = 2 * hstep;
    const unsigned ldsw = (unsigned)wid * 1024u;
    const int aoff = lds_byte(wr * 64 + fr, fq * 8), boff = lds_byte(wc * 32 + fr, fq * 8);
#define PG8_SA(b, h) (((b) * 2 + (h)) * HTB)
#define PG8_SB(b, h) ((4 + (b) * 2 + (h)) * HTB)
#define PG8_STAGE(bufoff, gbase, voff) do { _Pragma("unroll") for (int _i = 0; _i < 2; ++_i) \
        __builtin_amdgcn_global_load_lds((const unsigned*)((const char*)(gbase) + (voff)[_i]), (PG8_LAS unsigned*)(lds + (bufoff) + ldsw + _i * 8192), 16, 0, 0); } while (0)
#define PG8_LDA(dst, b, h) do { _Pragma("unroll") for (int m = 0; m < 4; ++m) _Pragma("unroll") for (int k = 0; k < 2; ++k) dst[m][k] = *(const PG8_LAS bf16x8*)(lds + PG8_SA(b, h) + aoff + m * 2048 + k * 1024); } while (0)
#define PG8_LDB(dst, b, h) do { _Pragma("unroll") for (int n = 0; n < 2; ++n) _Pragma("unroll") for (int k = 0; k < 2; ++k) dst[n][k] = *(const PG8_LAS bf16x8*)(lds + PG8_SB(b, h) + boff + n * 2048 + k * 1024); } while (0)
#define PG8_MMA(ai, bj, At, Bt) do { __builtin_amdgcn_s_setprio(1); _Pragma("unroll") for (int m = 0; m < 4; ++m) _Pragma("unroll") for (int n = 0; n < 2; ++n) _Pragma("unroll") for (int k = 0; k < 2; ++k) \
        acc[ai][bj][m][n] = __builtin_amdgcn_mfma_f32_16x16x32_bf16(Bt[n][k], At[m][k], acc[ai][bj][m][n], 0, 0, 0); __builtin_amdgcn_s_setprio(0); } while (0)
#define PG8_WAIT_V(n) asm volatile("s_waitcnt vmcnt(" #n ")" ::: "memory")
#define PG8_WAIT_L(n) asm volatile("s_waitcnt lgkmcnt(" #n ")" ::: "memory")
#define PG8_BAR __builtin_amdgcn_s_barrier()
#define PG8_SCHED __builtin_amdgcn_sched_barrier(0)
    Unit cur, nxt; int ui = 0;
    if (!S.next(0, cur)) return;
    f32x4 acc[2][2][4][2];
#pragma unroll
    for (int a = 0; a < 2; ++a)
#pragma unroll
        for (int b = 0; b < 2; ++b)
#pragma unroll
            for (int m = 0; m < 4; ++m)
#pragma unroll
                for (int n = 0; n < 2; ++n) acc[a][b][m][n] = (f32x4){0.f, 0.f, 0.f, 0.f};
    bf16x8 At[4][2], B0[2][2], B1[2][2];
    const char* cA = (const char*)g.A + (size_t)cur.pm * tstep; const char* cB = (const char*)g.Bt + (size_t)cur.pn * tstep;
    S.a_ready(cur);
    if constexpr (SP2) {
        PG8_STAGE(PG8_SB(0, 0), cB, voffB); PG8_STAGE(PG8_SB(0, 1), cB + hstep, voffB); PG8_STAGE(PG8_SA(0, 0), cA, voffA); PG8_STAGE(PG8_SA(0, 1), cA + hstep, voffA);
        if (wr == 1) PG8_BAR;
        PG8_WAIT_V(2); PG8_BAR;
        PG8_STAGE(PG8_SB(1, 0), cB + kstep, voffB); PG8_STAGE(PG8_SA(1, 0), cA + kstep, voffA); PG8_STAGE(PG8_SB(1, 1), cB + hstep + kstep, voffB);
        PG8_WAIT_V(6); PG8_BAR;
    } else {
        PG8_STAGE(PG8_SB(0, 0), cB, voffB); PG8_STAGE(PG8_SA(0, 0), cA, voffA); PG8_STAGE(PG8_SB(0, 1), cB + hstep, voffB); PG8_STAGE(PG8_SA(0, 1), cA + hstep, voffA);
        if (wr == 1) PG8_BAR;
        PG8_WAIT_V(4); PG8_BAR;
        PG8_STAGE(PG8_SB(1, 0), cB + kstep, voffB); PG8_STAGE(PG8_SA(1, 0), cA + kstep, voffA); PG8_STAGE(PG8_SB(1, 1), cB + hstep + kstep, voffB);
        PG8_WAIT_V(6); PG8_BAR;
    }
    for (;;) {
        const bool has_next = S.next(ui + 1, nxt);
        const char* nA = has_next ? (const char*)g.A + (size_t)nxt.pm * tstep : cA; const char* nB = has_next ? (const char*)g.Bt + (size_t)nxt.pn * tstep : cB;
        for (int t = 0; t < nt; t += 2) {
            const bool last = (t == nt - 2);
            const char* a1 = cA + (size_t)(t + 1) * kstep;
            const char* a2 = last ? nA : cA + (size_t)(t + 2) * kstep; const char* b2 = last ? nB : cB + (size_t)(t + 2) * kstep;
            const char* a3 = a2 + kstep; const char* b3 = b2 + kstep;
            if (last && has_next) S.a_ready(nxt);
            if constexpr (SP2) {
            PG8_LDB(B0, 0, 0); PG8_LDB(B1, 0, 1); PG8_SCHED; PG8_LDA(At, 0, 0); PG8_STAGE(PG8_SA(1, 1), a1 + hstep, voffA);
            PG8_WAIT_V(8); PG8_WAIT_L(0); PG8_BAR; PG8_MMA(0, 0, At, B0); PG8_MMA(0, 1, At, B1); PG8_BAR; PG8_SCHED;
            PG8_LDA(At, 0, 1); PG8_STAGE(PG8_SB(0, 0), b2, voffB); PG8_STAGE(PG8_SB(0, 1), b2 + hstep, voffB); PG8_STAGE(PG8_SA(0, 0), a2, voffA);
            PG8_WAIT_V(8); PG8_WAIT_L(0); PG8_BAR; PG8_MMA(1, 0, At, B0); PG8_MMA(1, 1, At, B1); PG8_BAR; PG8_SCHED;
            PG8_LDB(B0, 1, 0); PG8_LDB(B1, 1, 1); PG8_SCHED; PG8_LDA(At, 1, 0); PG8_STAGE(PG8_SA(0, 1), a2 + hstep, voffA);
            PG8_WAIT_V(8); PG8_WAIT_L(0); PG8_BAR; PG8_MMA(0, 0, At, B0); PG8_MMA(0, 1, At, B1); PG8_BAR; PG8_SCHED;
            PG8_LDA(At, 1, 1); PG8_STAGE(PG8_SB(1, 0), b3, voffB); PG8_STAGE(PG8_SB(1, 1), b3 + hstep, voffB); PG8_STAGE(PG8_SA(1, 0), a3, voffA);
            PG8_WAIT_V(8); PG8_WAIT_L(0); PG8_BAR; PG8_MMA(1, 0, At, B0); PG8_MMA(1, 1, At, B1); PG8_BAR; PG8_SCHED;
            } else {
            PG8_LDB(B0, 0, 0); PG8_SCHED; PG8_LDA(At, 0, 0); PG8_STAGE(PG8_SA(1, 1), a1 + hstep, voffA);
            PG8_WAIT_L(8); PG8_BAR; PG8_WAIT_L(0); PG8_MMA(0, 0, At, B0); PG8_BAR; PG8_SCHED;
            PG8_LDB(B1, 0, 1); PG8_STAGE(PG8_SB(0, 0), b2, voffB);
            PG8_BAR; PG8_WAIT_L(0); PG8_MMA(0, 1, At, B1); PG8_BAR;
            PG8_LDA(At, 0, 1); PG8_STAGE(PG8_SA(0, 0), a2, voffA);
            PG8_BAR; PG8_WAIT_L(0); PG8_MMA(1, 0, At, B0); PG8_BAR; PG8_SCHED;
            PG8_STAGE(PG8_SB(0, 1), b2 + hstep, voffB);
            PG8_WAIT_V(6); PG8_BAR; PG8_MMA(1, 1, At, B1); PG8_BAR;
            PG8_LDB(B0, 1, 0); PG8_SCHED; PG8_LDA(At, 1, 0); PG8_STAGE(PG8_SA(0, 1), a2 + hstep, voffA);
            PG8_WAIT_L(8); PG8_BAR; PG8_WAIT_L(0); PG8_MMA(0, 0, At, B0); PG8_BAR; PG8_SCHED;
            PG8_LDB(B1, 1, 1); PG8_STAGE(PG8_SB(1, 0), b3, voffB);
            PG8_BAR; PG8_WAIT_L(0); PG8_MMA(0, 1, At, B1); PG8_BAR;
            PG8_LDA(At, 1, 1); PG8_STAGE(PG8_SA(1, 0), a3, voffA);
            PG8_BAR; PG8_WAIT_L(0); PG8_MMA(1, 0, At, B0); PG8_BAR; PG8_SCHED;
            PG8_STAGE(PG8_SB(1, 1), b3 + hstep, voffB);
            PG8_WAIT_V(6); PG8_BAR; PG8_MMA(1, 1, At, B1); PG8_BAR;
            }
        }
        if constexpr (ALIGN_EPI) { if (wr == 0) PG8_BAR; }
        if constexpr (!Epi::AFTER_DRAIN) { E(acc, cur, wr, wc, fr, fq); S.done(cur); }
        if (!has_next) break;
#pragma unroll
        for (int a = 0; a < 2; ++a)
#pragma unroll
            for (int b = 0; b < 2; ++b)
#pragma unroll
                for (int m = 0; m < 4; ++m)
#pragma unroll
                    for (int n = 0; n < 2; ++n) acc[a][b][m][n] = (f32x4){0.f, 0.f, 0.f, 0.f};
        cur = nxt; cA = nA; cB = nB; ++ui;
        if constexpr (ALIGN_EPI) { if (wr == 1) PG8_BAR; }
    }
    PG8_WAIT_V(0);
    if constexpr (!ALIGN_EPI) { if (wr == 0) PG8_BAR; }
    PG8_BAR;
    if constexpr (Epi::AFTER_DRAIN) { E.fused(acc, cur, wr, wc, fr, fq, lds, wid, lane); S.done(cur); }
#undef PG8_SA
#undef PG8_SB
#undef PG8_STAGE
#undef PG8_LDA
#undef PG8_LDB
#undef PG8_MMA
#undef PG8_WAIT_V
#undef PG8_WAIT_L
#undef PG8_BAR
#undef PG8_SCHED
}
}
#define LAS __attribute__((address_space(3)))
typedef unsigned short bf16_t;
typedef short bf16x8 __attribute__((ext_vector_type(8)));
typedef short s16x4 __attribute__((ext_vector_type(4)));
typedef float f32x4 __attribute__((ext_vector_type(4)));
typedef float f32x2 __attribute__((ext_vector_type(2)));
typedef float f32x16 __attribute__((ext_vector_type(16)));
typedef unsigned u32x4 __attribute__((ext_vector_type(4)));
typedef unsigned u32x2 __attribute__((ext_vector_type(2)));
typedef __bf16 bf16x2_t __attribute__((ext_vector_type(2)));

constexpr int NWAVES = 8, NTHR = 512;
constexpr int M_ = 32768, SEQ = 8192, DM = 1024, NIN = 4608, DFF = 4096, CCH = 512, PLED = 256, NHEAD = 4;
constexpr int ZQ = 1024, ZK = 1536, ZV = 2048, ZGC = 2560, ZGA = 3584;
constexpr float LOG2E = 1.4426950408889634f;
constexpr float QSCALE = 0.125f * LOG2E;
constexpr float ALPHA = 1.189207115002721f;
constexpr float EPS = 1e-5f;
constexpr float LAMBDA_INIT = 0.2f;
constexpr int LDS_BYTES = 147456;

constexpr size_t MiB = 1u << 20;
constexpr size_t WS_Z = 0;
constexpr size_t WS_WIN = 288 * MiB;
constexpr size_t WS_WFF1 = 297 * MiB;
constexpr size_t WS_WFF2 = 307 * MiB;
constexpr size_t WS_WO = 315 * MiB;
constexpr size_t WS_WC = 317 * MiB;
constexpr size_t WS_WA = 318 * MiB;
constexpr size_t WS_WPLE = 319 * MiB;
constexpr size_t WS_ST0 = 320 * MiB;
constexpr size_t WS_ST1 = 321 * MiB;
constexpr size_t WS_CTL = 320 * MiB + 512 * 1024;
constexpr size_t WS_HB = 322 * MiB;
constexpr size_t WS_PE = 386 * MiB;
constexpr size_t WS_PB = 450 * MiB;
constexpr size_t WS_END = 466 * MiB;

__device__ __forceinline__ unsigned cvtpk(float lo, float hi) { f32x2 v = {lo, hi}; bf16x2_t b = __builtin_convertvector(v, bf16x2_t); return __builtin_bit_cast(unsigned, b); }
__device__ __forceinline__ float bflo(unsigned w) { return __uint_as_float(w << 16); }
__device__ __forceinline__ float bfhi(unsigned w) { return __uint_as_float(w & 0xffff0000u); }
__device__ __forceinline__ float sigm(float x) { return __builtin_amdgcn_rcpf(1.f + __builtin_amdgcn_exp2f(-x * LOG2E)); }
__device__ __forceinline__ float wave_sum(float v) {
#pragma unroll
    for (int o = 1; o < 64; o <<= 1) v += __shfl_xor(v, o);
    return v;
}
__device__ __forceinline__ void unpack8(const u32x4 w, f32x4& a, f32x4& b) {
    a = (f32x4){bflo(w.x), bfhi(w.x), bflo(w.y), bfhi(w.y)}; b = (f32x4){bflo(w.z), bfhi(w.z), bflo(w.w), bfhi(w.w)};
}
__device__ __forceinline__ u32x4 pack8(const f32x4 a, const f32x4 b) {
    u32x4 w; w.x = cvtpk(a[0], a[1]); w.y = cvtpk(a[2], a[3]); w.z = cvtpk(b[0], b[1]); w.w = cvtpk(b[2], b[3]); return w;
}

using pg8::Unit;
struct EpiZ {
    static constexpr bool PERM = true, AFTER_DRAIN = false;
    bf16_t* O; int ldc; int kind; unsigned* KM;
    __device__ __forceinline__ void operator()(const f32x4 (&acc)[2][2][4][2], const Unit& u, int wr, int wc, int fr, int fq) const {
        const int row0 = u.pm * 256 + wr * 64 + fr, col0 = u.pn * 256 + wc * 32 + 8 * fq;
        int mode = 0; if (kind == 0) mode = (u.pn == 4 || u.pn == 5) ? 1 : (u.pn >= 10 ? 2 : (u.pn == 6 || u.pn == 7) ? 3 : 0);
        float mx[2] = {0.f, 0.f};
#pragma unroll
        for (int ai = 0; ai < 2; ++ai)
#pragma unroll
            for (int m = 0; m < 4; ++m) { bf16_t* rowp = O + (size_t)(row0 + ai * 128 + m * 16) * ldc + col0;
#pragma unroll
                for (int bj = 0; bj < 2; ++bj) { f32x4 v0 = acc[ai][bj][m][0], v1 = acc[ai][bj][m][1];
                    if (mode == 1) { v0 = v0 * QSCALE; v1 = v1 * QSCALE; }
                    else if (mode == 2) {
#pragma unroll
                        for (int e = 0; e < 4; ++e) { v0[e] = sigm(v0[e]); v1[e] = sigm(v1[e]); } }
                    else if (mode == 3) {
                        float ss = (v0[0] * v0[0] + v0[1] * v0[1]) + (v0[2] * v0[2] + v0[3] * v0[3]) + (v1[0] * v1[0] + v1[1] * v1[1]) + (v1[2] * v1[2] + v1[3] * v1[3]);
                        ss += __shfl_xor(ss, 16); ss += __shfl_xor(ss, 32); mx[bj] = fmaxf(mx[bj], ss); }
                    *(u32x4*)(rowp + bj * 128) = pack8(v0, v1); } }
        if (mode == 3) {
#pragma unroll
            for (int bj = 0; bj < 2; ++bj) { float v = mx[bj];
#pragma unroll
                for (int o = 1; o < 16; o <<= 1) v = fmaxf(v, __shfl_xor(v, o));
                if (fr == 0 && fq == 0) atomicMax(KM + ((((u.pm >> 5) * 4 + (u.pn - 6) * 2 + bj) * 2 + (wc >> 1)) * 2 + (wc & 1)), __float_as_uint(v)); }
        }
    }
};
struct EpiGate {
    static constexpr bool PERM = true, AFTER_DRAIN = false;
    bf16_t* MG; const bf16_t* Z; int gcol; int add;
    __device__ __forceinline__ void operator()(const f32x4 (&acc)[2][2][4][2], const Unit& u, int wr, int wc, int fr, int fq) const {
        const int row0 = u.pm * 256 + wr * 64 + fr, col0 = u.pn * 256 + wc * 32 + 8 * fq;
#pragma unroll
        for (int ai = 0; ai < 2; ++ai)
#pragma unroll
            for (int m = 0; m < 4; ++m) { const size_t row = (size_t)(row0 + ai * 128 + m * 16);
#pragma unroll
                for (int bj = 0; bj < 2; ++bj) { const int col = col0 + bj * 128;
                    const u32x4 gw = *(const u32x4*)(Z + row * NIN + gcol + col); f32x4 g0, g1; unpack8(gw, g0, g1);
                    f32x4 v0 = acc[ai][bj][m][0] * g0, v1 = acc[ai][bj][m][1] * g1;
                    bf16_t* dst = MG + row * DM + col;
                    if (add) { const u32x4 pw = *(const u32x4*)dst; f32x4 p0, p1; unpack8(pw, p0, p1); v0 = v0 + p0; v1 = v1 + p1; }
                    *(u32x4*)dst = pack8(v0, v1); } }
    }
};
struct EpiRes {
    static constexpr bool PERM = false, AFTER_DRAIN = false;
    const float* src; const float* st; const float* g; const float* b; const bf16_t* ple; float* out;
    __device__ __forceinline__ void operator()(const f32x4 (&acc)[2][2][4][2], const Unit& u, int wr, int wc, int fr, int fq) const {
        const int row0 = u.pm * 256 + wr * 64 + fr, col0 = u.pn * 256 + wc * 32 + 4 * fq;
#pragma unroll
        for (int ai = 0; ai < 2; ++ai)
#pragma unroll
            for (int m = 0; m < 4; ++m) { const size_t row = (size_t)(row0 + ai * 128 + m * 16); const f32x2 s = *(const f32x2*)(st + row * 2);
#pragma unroll
                for (int bj = 0; bj < 2; ++bj)
#pragma unroll
                    for (int n = 0; n < 2; ++n) { const int col = col0 + bj * 128 + n * 16;
                        const f32x4 xv = *(const f32x4*)(src + row * DM + col); const f32x4 gv = *(const f32x4*)(g + col), bv = *(const f32x4*)(b + col);
                        f32x4 o = ((xv - s.x) * s.y * gv + bv) * ALPHA + acc[ai][bj][m][n];
                        if (ple) { const u32x2 pw = *(const u32x2*)(ple + row * DM + col); o = o + (f32x4){bflo(pw.x), bfhi(pw.x), bflo(pw.y), bfhi(pw.y)}; }
                        *(f32x4*)(out + row * DM + col) = o; }
                asm volatile("" ::: "memory"); }
    }
};
struct EpiFF1 {
    static constexpr bool PERM = true, AFTER_DRAIN = false;
    bf16_t* FF1; bf16_t* PE;
    __device__ __forceinline__ void operator()(const f32x4 (&acc)[2][2][4][2], const Unit& u, int wr, int wc, int fr, int fq) const {
        const int row0 = u.pm * 256 + wr * 64 + fr;
        if (u.pn < 16) {
            const int col0 = u.pn * 256 + wc * 32 + 8 * fq;
#pragma unroll
            for (int ai = 0; ai < 2; ++ai)
#pragma unroll
                for (int m = 0; m < 4; ++m) { bf16_t* rowp = FF1 + (size_t)(row0 + ai * 128 + m * 16) * DFF + col0;
#pragma unroll
                    for (int bj = 0; bj < 2; ++bj) { f32x4 v0 = acc[ai][bj][m][0], v1 = acc[ai][bj][m][1];
#pragma unroll
                        for (int e = 0; e < 4; ++e) { const float a = fmaxf(v0[e], 0.f), c = fmaxf(v1[e], 0.f); v0[e] = a * a; v1[e] = c * c; }
                        *(u32x4*)(rowp + bj * 128) = pack8(v0, v1); } }
        } else {
            const int col0 = (u.pn - 16) * 256 + wc * 32 + 8 * fq;
#pragma unroll
            for (int ai = 0; ai < 2; ++ai)
#pragma unroll
                for (int m = 0; m < 4; ++m) { bf16_t* rowp = PE + (size_t)(row0 + ai * 128 + m * 16) * DM + col0;
#pragma unroll
                    for (int bj = 0; bj < 2; ++bj) { f32x4 v0 = acc[ai][bj][m][0], v1 = acc[ai][bj][m][1];
                        const u32x4 pw = *(const u32x4*)(rowp + bj * 128); f32x4 p0, p1; unpack8(pw, p0, p1);
#pragma unroll
                        for (int e = 0; e < 4; ++e) { v0[e] = sigm(v0[e]) * p0[e]; v1[e] = sigm(v1[e]) * p1[e]; }
                        *(u32x4*)(rowp + bj * 128) = pack8(v0, v1); } }
        }
    }
};

__device__ __forceinline__ unsigned f2bf(float f) { unsigned u = __float_as_uint(f); return (u + 0x7fffu + ((u >> 16) & 1u)) >> 16; }
__device__ __forceinline__ unsigned pk2(float lo, float hi) { return f2bf(lo) | (f2bf(hi) << 16); }
__device__ __forceinline__ void transpose_item(const float* W, int K, int N, bf16_t* WT, int row_off, LAS float* scr, int item, int lane) {
    const int nblk = N / 32, kb = item / nblk, nb = item % nblk, k0 = 64 * kb, n0 = 32 * nb;
#pragma unroll 8
    for (int i = 0; i < 32; ++i) { const int kk = 2 * i + (lane >> 5); scr[kk * 33 + (lane & 31)] = W[(size_t)(k0 + kk) * N + n0 + (lane & 31)]; }
    asm volatile("s_waitcnt lgkmcnt(0)" ::: "memory");
    const int c = lane & 7;
#pragma unroll
    for (int j = 0; j < 4; ++j) { const int n = (lane >> 3) + 8 * j; const LAS float* s = scr + (8 * c) * 33 + n;
        u32x4 o; o.x = pk2(s[0 * 33], s[1 * 33]); o.y = pk2(s[2 * 33], s[3 * 33]); o.z = pk2(s[4 * 33], s[5 * 33]); o.w = pk2(s[6 * 33], s[7 * 33]);
        *(u32x4*)(WT + (size_t)(row_off + n0 + n) * K + k0 + 8 * c) = o; }
    asm volatile("s_waitcnt lgkmcnt(0)" ::: "memory");
}
template <int MODE> __device__ __forceinline__ void ln_rows(const float* src, bf16_t* dstb, float* dstf, float* st, const float* g, const float* b, int gw, int ngw, int lane) {
    f32x4 gv[4], bv[4];
#pragma unroll
    for (int j = 0; j < 4; ++j) { gv[j] = *((const f32x4*)g + lane + 64 * j); bv[j] = *((const f32x4*)b + lane + 64 * j); }
    for (int row = gw; row < M_; row += ngw) {
        const f32x4* xr = (const f32x4*)(src + (size_t)row * DM) + lane;
        f32x4 v[4]; float s = 0.f;
#pragma unroll
        for (int j = 0; j < 4; ++j) { v[j] = xr[64 * j]; s += (v[j][0] + v[j][1]) + (v[j][2] + v[j][3]); }
        const float mean = wave_sum(s) * (1.f / DM); float s2 = 0.f;
#pragma unroll
        for (int j = 0; j < 4; ++j) { v[j] = v[j] - mean; s2 += (v[j][0] * v[j][0] + v[j][1] * v[j][1]) + (v[j][2] * v[j][2] + v[j][3] * v[j][3]); }
        const float rstd = 1.f / sqrtf(wave_sum(s2) * (1.f / DM) + EPS);
        if (MODE == 0) {
            u32x2* o8 = (u32x2*)(dstb + (size_t)row * DM) + lane;
#pragma unroll
            for (int j = 0; j < 4; ++j) { const f32x4 y = v[j] * rstd * gv[j] + bv[j]; u32x2 w; w.x = cvtpk(y[0], y[1]); w.y = cvtpk(y[2], y[3]); o8[64 * j] = w; }
            if (lane == 0) *(f32x2*)(st + (size_t)row * 2) = (f32x2){mean, rstd};
        } else {
            f32x4* o = (f32x4*)(dstf + (size_t)row * DM) + lane;
#pragma unroll
            for (int j = 0; j < 4; ++j) o[64 * j] = v[j] * rstd * gv[j] + bv[j];
        }
    }
}

__device__ __forceinline__ void conv_unit(LAS unsigned char* lds, const bf16_t* Z, bf16_t* UC, const float* cw, const float* lg, const float* lb, int unit) {
    const int tid = threadIdx.x, lane = tid & 63, wid = tid >> 6;
    const int m0 = unit * 32, s0 = m0 % SEQ;
    float w[31];
#pragma unroll
    for (int k = 0; k < 31; ++k) w[k] = cw[k * CCH + tid];
    float uw[62];
#pragma unroll
    for (int i = 0; i < 62; ++i) {
        float v = 0.f;
        if (s0 - 30 + i >= 0) { const bf16_t* zp = Z + (size_t)(m0 - 30 + i) * NIN + tid; const float a = __uint_as_float((unsigned)zp[0] << 16), gg = __uint_as_float((unsigned)zp[CCH] << 16); v = a * sigm(gg); }
        uw[i] = v;
    }
    LAS float* yl = (LAS float*)lds;
#pragma unroll
    for (int j = 0; j < 32; ++j) { float y = 0.f;
#pragma unroll
        for (int k = 0; k < 31; ++k) y += w[k] * uw[j + k];
        yl[j * CCH + tid] = y; }
    __syncthreads();
#pragma unroll
    for (int rr = 0; rr < 4; ++rr) { const int row = wid * 4 + rr;
        f32x4 v[2]; float s = 0.f;
#pragma unroll
        for (int i = 0; i < 2; ++i) { v[i] = *(const LAS f32x4*)(yl + row * CCH + lane * 4 + 256 * i); s += (v[i][0] + v[i][1]) + (v[i][2] + v[i][3]); }
        const float mean = wave_sum(s) * (1.f / CCH); float s2 = 0.f;
#pragma unroll
        for (int i = 0; i < 2; ++i) { v[i] = v[i] - mean; s2 += (v[i][0] * v[i][0] + v[i][1] * v[i][1]) + (v[i][2] * v[i][2] + v[i][3] * v[i][3]); }
        const float rstd = 1.f / sqrtf(wave_sum(s2) * (1.f / CCH) + EPS);
#pragma unroll
        for (int i = 0; i < 2; ++i) { const int col = lane * 4 + 256 * i; const f32x4 gv = *(const f32x4*)(lg + col), bv = *(const f32x4*)(lb + col);
            f32x4 y = v[i] * rstd * gv + bv;
#pragma unroll
            for (int e = 0; e < 4; ++e) y[e] = y[e] * sigm(y[e]);
            u32x2 o; o.x = cvtpk(y[0], y[1]); o.y = cvtpk(y[2], y[3]); *(u32x2*)(UC + (size_t)(m0 + row) * CCH + col) = o; }
    }
    __syncthreads();
}

constexpr int A_KSTR = 144, A_VSTR = 320, A_KB = 64 * A_KSTR, A_VB = 64 * A_VSTR, A_BUF = 2 * A_KB + A_VB, A_SCR = 2 * A_BUF;
__device__ __forceinline__ int crow(int r, int hi) { return (r & 3) + 8 * (r >> 2) + 4 * hi; }
__device__ __forceinline__ s16x4 vtr(const LAS unsigned char* p) { return __builtin_bit_cast(s16x4, __builtin_amdgcn_ds_read_tr16_b64_v4i16((LAS s16x4*)p)); }

__device__ __forceinline__ void attn_unit(LAS unsigned char* lds, const bf16_t* Z, bf16_t* OA, const float* subg, const unsigned* KM, int b, int h, int qb, float lam) {
    const int tid = threadIdx.x, lane = tid & 63, r32 = lane & 31, hi = lane >> 5;
    const int wid = __builtin_amdgcn_readfirstlane(tid >> 6), rg = wid >> 1, c = wid & 1;
    const size_t brow0 = (size_t)b * SEQ;
    const int q0 = qb * 128, qpos = q0 + 32 * rg + r32;
    const float slope2 = __builtin_amdgcn_exp2f(-2.f * (float)(h + 1)) * LOG2E;
    bf16x8 qf[4];
    { const bf16_t* qp = Z + (brow0 + qpos) * NIN + ZQ + h * 128 + c * 64 + hi * 8;
#pragma unroll
      for (int s = 0; s < 4; ++s) qf[s] = *(const bf16x8*)(qp + 16 * s); }
    const int skey = tid >> 4, sch = tid & 15;
    const bf16_t* gsrc = Z + (brow0 + skey) * NIN + h * 128 + sch * 8;
    const int kdst = (sch >> 3) * A_KB + skey * A_KSTR + (sch & 7) * 16, vdst = 2 * A_KB + skey * A_VSTR + sch * 16;
    u32x4 stg[4];
#define A_GLOAD(t) do { const bf16_t* p_ = gsrc + (size_t)(64 * (t)) * NIN; stg[0] = *(const u32x4*)(p_ + ZK); stg[1] = *(const u32x4*)(p_ + ZK + 32 * NIN); \
        stg[2] = *(const u32x4*)(p_ + ZV); stg[3] = *(const u32x4*)(p_ + ZV + 32 * NIN); } while (0)
#define A_LWRITE(bufo) do { LAS unsigned char* d_ = lds + (bufo); *(LAS u32x4*)(d_ + kdst) = stg[0]; *(LAS u32x4*)(d_ + kdst + 32 * A_KSTR) = stg[1]; \
        *(LAS u32x4*)(d_ + vdst) = stg[2]; *(LAS u32x4*)(d_ + vdst + 32 * A_VSTR) = stg[3]; } while (0)
    const int nt = 2 * (qb + 1);
    LAS float* wscr = (LAS float*)(lds + A_SCR) + wid * 32;
    const int koff = c * A_KB + r32 * A_KSTR + hi * 16;
    const int voff = 2 * A_KB + (4 * hi + ((lane & 15) >> 2)) * A_VSTR + (16 * ((lane >> 4) & 1) + 4 * (lane & 3)) * 2;
    f32x16 O[4];
#pragma unroll
    for (int d = 0; d < 4; ++d)
#pragma unroll
        for (int r = 0; r < 16; ++r) O[d][r] = 0.f;
    float mrun, lrun = 0.f; int t_lo;
    { const bf16_t* kp = Z + (brow0 + qpos) * NIN + ZK + h * 128 + c * 64 + hi * 8;
      float qa = 0.f, qbn = 0.f, dot = 0.f;
#pragma unroll
      for (int s = 0; s < 4; ++s) { const bf16x8 kd = *(const bf16x8*)(kp + 16 * s);
#pragma unroll
          for (int e = 0; e < 8; ++e) { const float qv = __uint_as_float((unsigned)(unsigned short)qf[s][e] << 16), kv = __uint_as_float((unsigned)(unsigned short)kd[e] << 16);
              if (s < 2) qa += qv * qv; else qbn += qv * qv; dot += qv * kv; } }
      qa += __shfl_xor(qa, 32); qbn += __shfl_xor(qbn, 32); dot += __shfl_xor(dot, 32);
      const unsigned* km = KM + ((b * 4 + h) * 2 + c) * 2;
      const float kma = sqrtf(__uint_as_float(km[0])), kmb = sqrtf(__uint_as_float(km[1]));
      const float bnum = (sqrtf(qa) * kma + sqrtf(qbn) * kmb) * 1.01f - dot + 40.f;
      float kmin = (float)qpos - bnum / slope2;
#pragma unroll
      for (int o = 1; o < 64; o <<= 1) kmin = fminf(kmin, __shfl_xor(kmin, o));
      if (lane == 0) ((LAS float*)(lds + A_SCR + 1024))[wid] = kmin;
      mrun = dot; }
    A_GLOAD(nt - 1); A_LWRITE(0); __syncthreads();
    { float kmin = ((LAS float*)(lds + A_SCR + 1024))[0];
#pragma unroll
      for (int w = 1; w < 8; ++w) kmin = fminf(kmin, ((LAS float*)(lds + A_SCR + 1024))[w]);
      t_lo = kmin <= 0.f ? 0 : (int)(kmin * (1.f / 64.f)); if (t_lo > nt - 1) t_lo = nt - 1; t_lo = __builtin_amdgcn_readfirstlane(t_lo); }
    int bufo = 0;
    for (int t = nt - 1; t >= t_lo; --t) {
        if (t > t_lo) A_GLOAD(t - 1);
        const bool skip = (64 * t > q0 + 32 * rg + 31);
        if (!skip) {
            const LAS unsigned char* Kb = lds + bufo + koff;
            const LAS unsigned char* Vb = lds + bufo + voff;
            const float base = slope2 * (float)(64 * t + 4 * hi - qpos) - mrun;
            const float base1 = base + 32.f * slope2;
            f32x16 S0, S1;
#pragma unroll
            for (int r = 0; r < 16; ++r) { const float kr = (float)((r & 3) + 8 * (r >> 2)); S0[r] = __builtin_fmaf(slope2, kr, base); S1[r] = __builtin_fmaf(slope2, kr, base1); }
#pragma unroll
            for (int s = 0; s < 4; ++s) {
                const bf16x8 k0 = *(const LAS bf16x8*)(Kb + s * 32), k1 = *(const LAS bf16x8*)(Kb + 32 * A_KSTR + s * 32);
                S0 = __builtin_amdgcn_mfma_f32_32x32x16_bf16(k0, qf[s], S0, 0, 0, 0);
                S1 = __builtin_amdgcn_mfma_f32_32x32x16_bf16(k1, qf[s], S1, 0, 0, 0);
            }
            if (t >= nt - 2) { const int kb = 64 * (t - (nt - 2)), qrel = 32 * rg + r32;
#pragma unroll
                for (int r = 0; r < 16; ++r) { const int kr = kb + crow(r, hi); if (kr > qrel) S0[r] = -1e30f; if (kr + 32 > qrel) S1[r] = -1e30f; } }
            float rm = fmaxf(S0[0], S1[0]);
#pragma unroll
            for (int r = 1; r < 16; ++r) rm = fmaxf(rm, fmaxf(S0[r], S1[r]));
            rm = fmaxf(rm, __shfl_xor(rm, 32));
            const bool need = rm > 8.f;
            if (__any(need)) {
                const float dl = need ? rm : 0.f; const float al = __builtin_amdgcn_exp2f(-dl);
                lrun *= al; mrun += dl;
                if (hi == 0) wscr[r32] = al;
#pragma unroll
                for (int r = 0; r < 16; ++r) { const float a = wscr[crow(r, hi)]; S0[r] -= dl; S1[r] -= dl;
#pragma unroll
                    for (int d = 0; d < 4; ++d) O[d][r] *= a; }
            }
            float ls = 0.f;
#pragma unroll
            for (int r = 0; r < 16; ++r) { S0[r] = __builtin_amdgcn_exp2f(S0[r]); S1[r] = __builtin_amdgcn_exp2f(S1[r]); ls += S0[r] + S1[r]; }
            lrun += ls;
            bf16x8 pa[4];
            { u32x4 w;
              w.x = cvtpk(S0[0], S0[1]); w.y = cvtpk(S0[2], S0[3]); w.z = cvtpk(S0[4], S0[5]); w.w = cvtpk(S0[6], S0[7]); pa[0] = __builtin_bit_cast(bf16x8, w);
              w.x = cvtpk(S0[8], S0[9]); w.y = cvtpk(S0[10], S0[11]); w.z = cvtpk(S0[12], S0[13]); w.w = cvtpk(S0[14], S0[15]); pa[1] = __builtin_bit_cast(bf16x8, w);
              w.x = cvtpk(S1[0], S1[1]); w.y = cvtpk(S1[2], S1[3]); w.z = cvtpk(S1[4], S1[5]); w.w = cvtpk(S1[6], S1[7]); pa[2] = __builtin_bit_cast(bf16x8, w);
              w.x = cvtpk(S1[8], S1[9]); w.y = cvtpk(S1[10], S1[11]); w.z = cvtpk(S1[12], S1[13]); w.w = cvtpk(S1[14], S1[15]); pa[3] = __builtin_bit_cast(bf16x8, w); }
#pragma unroll
            for (int d = 0; d < 4; ++d)
#pragma unroll
                for (int ks = 0; ks < 4; ++ks) {
                    const s16x4 lo = vtr(Vb + (16 * ks) * A_VSTR + d * 64), hh = vtr(Vb + (16 * ks + 8) * A_VSTR + d * 64);
                    const bf16x8 vf = __builtin_shufflevector(lo, hh, 0, 1, 2, 3, 4, 5, 6, 7);
                    O[d] = __builtin_amdgcn_mfma_f32_32x32x16_bf16(pa[ks], vf, O[d], 0, 0, 0);
                    if (ks == 3) __builtin_amdgcn_sched_barrier(0);
                }
        }
        if (t > t_lo) A_LWRITE(bufo ^ A_BUF);
        __syncthreads();
        bufo ^= A_BUF;
    }
#undef A_GLOAD
#undef A_LWRITE
    lrun += __shfl_xor(lrun, 32);
    { const float f = (c == 0 ? 1.f : -lam) / lrun;
      if (hi == 0) wscr[r32] = f;
#pragma unroll
      for (int r = 0; r < 16; ++r) { const float a = wscr[crow(r, hi)];
#pragma unroll
          for (int d = 0; d < 4; ++d) O[d][r] *= a; } }
    LAS float* xch = (LAS float*)lds + rg * 4096;
    if (c == 1) {
#pragma unroll
        for (int d = 0; d < 4; ++d)
#pragma unroll
            for (int r = 0; r < 16; ++r) xch[(d * 16 + r) * 64 + lane] = O[d][r];
    }
    __syncthreads();
    if (c == 0) {
        float ssq[16];
#pragma unroll
        for (int r = 0; r < 16; ++r) { float s = 0.f;
#pragma unroll
            for (int d = 0; d < 4; ++d) { O[d][r] += xch[(d * 16 + r) * 64 + lane]; s += O[d][r] * O[d][r]; }
            ssq[r] = s; }
#pragma unroll
        for (int o = 1; o < 32; o <<= 1)
#pragma unroll
            for (int r = 0; r < 16; ++r) ssq[r] += __shfl_xor(ssq[r], o);
        float gsc[4];
#pragma unroll
        for (int d = 0; d < 4; ++d) gsc[d] = subg[h * 128 + 32 * d + r32] * (1.f - LAMBDA_INIT);
        bf16_t* ob = OA + (brow0 + q0) * CCH + h * 128;
        const unsigned off0 = (unsigned)((32 * rg + 4 * hi) * CCH + r32);
#pragma unroll
        for (int r = 0; r < 16; ++r) { const float rs = __builtin_amdgcn_rsqf(ssq[r] * (1.f / 128.f) + EPS);
            const unsigned offr = off0 + (unsigned)(((r & 3) + 8 * (r >> 2)) * CCH);
#pragma unroll
            for (int d = 0; d < 4; ++d) ob[offr + 32 * d] = (bf16_t)(cvtpk(O[d][r] * rs * gsc[d], 0.f) & 0xffffu);
            asm volatile("" ::: "memory"); }
    }
    __syncthreads();
}

struct Args {
    const float *x, *p, *ln0g, *ln0b, *w_in, *conv_w, *cln_g, *cln_b, *w_conv_out, *lq1, *lk1, *lq2, *lk2, *subg, *w_attn_out, *w_o,
                *ln1g, *ln1b, *w_ff1, *w_ff2, *w_ple, *w_pg, *ln2g, *ln2b;
    float* out; unsigned char* ws; int ph_lo, ph_hi;
};
constexpr int NPHASE = 9;
#ifndef REP_ATT
#define REP_ATT 1
#endif
#ifndef REP_P1
#define REP_P1 1
#endif
#ifndef REP_CONV
#define REP_CONV 1
#endif
#ifndef REP_P0
#define REP_P0 1
#endif

__global__ void __launch_bounds__(NTHR, 2) fwd_kernel(Args a) {
    extern __shared__ __attribute__((aligned(16))) unsigned char lds_raw[];
    LAS unsigned char* lds = (LAS unsigned char*)lds_raw;
    const int tid = threadIdx.x, lane = tid & 63, wid = __builtin_amdgcn_readfirstlane(tid >> 6);
    const int G = gridDim.x, bx = blockIdx.x;
    const int vcu = (G % 8 == 0) ? (bx % 8) * (G / 8) + bx / 8 : bx;
    const int gw = vcu * NWAVES + wid, ngw = G * NWAVES;
    unsigned char* ws = a.ws;
    bf16_t* Zb = (bf16_t*)(ws + WS_Z); bf16_t* FF1 = (bf16_t*)(ws + WS_Z);
    bf16_t *WIN = (bf16_t*)(ws + WS_WIN), *WFF1 = (bf16_t*)(ws + WS_WFF1), *WFF2 = (bf16_t*)(ws + WS_WFF2), *WO = (bf16_t*)(ws + WS_WO),
           *WC = (bf16_t*)(ws + WS_WC), *WA = (bf16_t*)(ws + WS_WA), *WPLE = (bf16_t*)(ws + WS_WPLE);
    float *ST0 = (float*)(ws + WS_ST0), *ST1 = (float*)(ws + WS_ST1); unsigned* CTL = (unsigned*)(ws + WS_CTL);
    bf16_t *HB = (bf16_t*)(ws + WS_HB), *PE = (bf16_t*)(ws + WS_PE), *PB = (bf16_t*)(ws + WS_PB);
    bf16_t *UC = (bf16_t*)a.out, *OA = (bf16_t*)a.out + (size_t)M_ * CCH;
    const int lo = a.ph_lo, hi = a.ph_hi;
    cg::grid_group grid = cg::this_grid();
#define IN(k) (lo <= (k) && (k) < hi)
#define SEAM(k) do { if (IN(k) && IN((k) + 1)) grid.sync(); } while (0)

    if (IN(0)) for (int rep = 0; rep < REP_P0; ++rep) {
        LAS float* scr = (LAS float*)(lds + wid * 16384);
        if (bx == 0 && tid < 128) CTL[tid] = 0u;
        constexpr int I_IN = 16 * 144, I_C = 8 * 32, I_A = 8 * 32, I_O = 16 * 32, I_F1 = 16 * 128, I_PG = 16 * 32, I_F2 = 64 * 32, I_PL = 4 * 32;
        constexpr int NIT = I_IN + I_C + I_A + I_O + I_F1 + I_PG + I_F2 + I_PL;
        for (int it = gw; it < NIT; it += ngw) {
            int r = it;
            if (r < I_IN) { transpose_item(a.w_in, DM, NIN, WIN, 0, scr, r, lane); continue; } r -= I_IN;
            if (r < I_C) { transpose_item(a.w_conv_out, CCH, DM, WC, 0, scr, r, lane); continue; } r -= I_C;
            if (r < I_A) { transpose_item(a.w_attn_out, CCH, DM, WA, 0, scr, r, lane); continue; } r -= I_A;
            if (r < I_O) { transpose_item(a.w_o, DM, DM, WO, 0, scr, r, lane); continue; } r -= I_O;
            if (r < I_F1) { transpose_item(a.w_ff1, DM, DFF, WFF1, 0, scr, r, lane); continue; } r -= I_F1;
            if (r < I_PG) { transpose_item(a.w_pg, DM, DM, WFF1, DFF, scr, r, lane); continue; } r -= I_PG;
            if (r < I_F2) { transpose_item(a.w_ff2, DFF, DM, WFF2, 0, scr, r, lane); continue; } r -= I_F2;
            transpose_item(a.w_ple, PLED, DM, WPLE, 0, scr, r, lane);
        }
        ln_rows<0>(a.x, HB, nullptr, ST0, a.ln0g, a.ln0b, gw, ngw, lane);
        for (size_t i = (size_t)(vcu * NTHR + tid); i < (size_t)M_ * PLED / 8; i += (size_t)G * NTHR) {
            const f32x4 v0 = *((const f32x4*)a.p + 2 * i), v1 = *((const f32x4*)a.p + 2 * i + 1);
            *((u32x4*)PB + i) = pack8(v0, v1);
        }
    }
    SEAM(0);
    if (IN(1)) for (int rep = 0; rep < REP_P1; ++rep) {
        { pg8::Gemm g{HB, WIN, M_, NIN, DM}; pg8::StaticOrder S; S.init(M_, NIN, G, bx); EpiZ E{Zb, NIN, 0, CTL + 64};
          pg8::gemm_phase<EpiZ, pg8::StaticOrder, true, true>(lds, g, S, E); }
        { pg8::Gemm g{PB, WPLE, M_, DM, PLED}; pg8::StaticOrder S; S.init(M_, DM, G, bx); EpiZ E{PE, DM, 1, nullptr};
          pg8::gemm_phase<EpiZ, pg8::StaticOrder, true, true>(lds, g, S, E); }
    }
    SEAM(1);
    if (IN(2)) {
        float lam;
        { const float a1 = wave_sum(a.lq1[lane] * a.lk1[lane]), a2 = wave_sum(a.lq2[lane] * a.lk2[lane]); lam = expf(a1) - expf(a2) + LAMBDA_INIT; }
        LAS unsigned* qw = (LAS unsigned*)(lds + A_SCR + 1024 + 64);
        for (;;) {
            if (tid == 0) *qw = atomicAdd(CTL, 1u);
            __syncthreads();
            const int u = (int)*qw;
            __syncthreads();
            if (u >= 1024) break;
            const int qb = 63 - (u >> 4), bh = u & 15; attn_unit(lds, Zb, OA, a.subg, CTL + 64, bh >> 2, bh & 3, qb, lam);
        }
        for (;;) {
            if (tid == 0) *qw = atomicAdd(CTL + 1, 1u);
            __syncthreads();
            const int u = (int)*qw;
            __syncthreads();
            if (u >= 1024) break;
            conv_unit(lds, Zb, UC, a.conv_w, a.cln_g, a.cln_b, u);
        }
    }
    SEAM(2);
    if (IN(3)) {
        { pg8::Gemm g{UC, WC, M_, DM, CCH}; pg8::StaticOrder S; S.init(M_, DM, G, bx); EpiGate E{HB, Zb, ZGC, 0};
          pg8::gemm_phase<EpiGate, pg8::StaticOrder, true, true>(lds, g, S, E); }
        { pg8::Gemm g{OA, WA, M_, DM, CCH}; pg8::StaticOrder S; S.init(M_, DM, G, bx); EpiGate E{HB, Zb, ZGA, 1};
          pg8::gemm_phase<EpiGate, pg8::StaticOrder, true, true>(lds, g, S, E); }
    }
    SEAM(3);
    if (IN(4)) {
        pg8::Gemm g{HB, WO, M_, DM, DM}; pg8::StaticOrder S; S.init(M_, DM, G, bx); EpiRes E{a.x, ST0, a.ln0g, a.ln0b, nullptr, a.out};
        pg8::gemm_phase<EpiRes, pg8::StaticOrder, true, true>(lds, g, S, E);
    }
    SEAM(4);
    if (IN(5)) ln_rows<0>(a.out, HB, nullptr, ST1, a.ln1g, a.ln1b, gw, ngw, lane);
    SEAM(5);
    if (IN(6)) {
        pg8::Gemm g{HB, WFF1, M_, DFF + DM, DM}; pg8::StaticOrder S; S.init(M_, DFF + DM, G, bx); EpiFF1 E{FF1, PE};
        pg8::gemm_phase<EpiFF1, pg8::StaticOrder, true, true>(lds, g, S, E);
    }
    SEAM(6);
    if (IN(7)) {
        pg8::Gemm g{FF1, WFF2, M_, DM, DFF}; pg8::StaticOrder S; S.init(M_, DM, G, bx); EpiRes E{a.out, ST1, a.ln1g, a.ln1b, PE, a.out};
        pg8::gemm_phase<EpiRes, pg8::StaticOrder, true, true>(lds, g, S, E);
    }
    SEAM(7);
    if (IN(8)) ln_rows<1>(a.out, nullptr, a.out, nullptr, a.ln2g, a.ln2b, gw, ngw, lane);
#undef IN
#undef SEAM
}

#ifndef REP_PHASE
#define REP_PHASE -1
#endif
#ifndef N_LAUNCH_MODE
#define N_LAUNCH_MODE 0
#endif
extern "C" void kernel_launch(void* const* d_in, const int* in_sizes, int n_in, void* d_out, int out_size, void* d_ws, size_t ws_size, hipStream_t stream) {
    static int grid = 0;
    if (grid == 0) {
        int dev = 0, cus = 0, per_cu = 0;
        if (n_in != 24 || out_size != M_ * DM || ws_size < WS_END) { fprintf(stderr, "kernel_launch: unexpected shapes (n_in %d out %d ws %zu)\n", n_in, out_size, ws_size); grid = -1; return; }
        (void)hipGetDevice(&dev); (void)hipDeviceGetAttribute(&cus, hipDeviceAttributeMultiprocessorCount, dev);
        if (hipFuncSetAttribute((const void*)fwd_kernel, hipFuncAttributeMaxDynamicSharedMemorySize, LDS_BYTES) != hipSuccess) { fprintf(stderr, "kernel_launch: hipFuncSetAttribute failed\n"); grid = -1; return; }
        if (hipOccupancyMaxActiveBlocksPerMultiprocessor(&per_cu, (const void*)fwd_kernel, NTHR, LDS_BYTES) != hipSuccess || per_cu < 1) { fprintf(stderr, "kernel_launch: occupancy query says %d\n", per_cu); per_cu = 1; }
        (void)hipGetLastError();
        grid = cus * 1;
        if (per_cu < 1) grid = cus;
    }
    if (grid < 0) return;
    Args a{};
    const float** f = (const float**)&a;
    for (int i = 0; i < 24; ++i) f[i] = (const float*)d_in[i];
    a.out = (float*)d_out; a.ws = (unsigned char*)d_ws;
#if N_LAUNCH_MODE == 0
    a.ph_lo = 0; a.ph_hi = NPHASE;
    void* args[] = {&a};
    hipError_t e = hipLaunchCooperativeKernel((const void*)fwd_kernel, dim3(grid), dim3(NTHR), args, LDS_BYTES, stream);
    if (e != hipSuccess) fprintf(stderr, "cooperative launch failed: %s (grid %d)\n", hipGetErrorString(e), grid);
#else
    for (int ph = 0; ph < NPHASE; ++ph) { a.ph_lo = ph; a.ph_hi = ph + 1; hipLaunchKernelGGL(fwd_kernel, dim3(grid), dim3(NTHR), LDS_BYTES, stream, a);
        if (ph == REP_PHASE) hipLaunchKernelGGL(fwd_kernel, dim3(grid), dim3(NTHR), LDS_BYTES, stream, a); }
#endif
}
```

```cpp
#include <hip/hip_runtime.h>
#include <hip/hip_cooperative_groups.h>
#include <cstdio>
#include <cstdint>
namespace cg = cooperative_groups;
namespace pg8 {
#define PG8_LAS __attribute__((address_space(3)))
typedef unsigned short bf16_t;
typedef short bf16x8 __attribute__((ext_vector_type(8)));
typedef float f32x4 __attribute__((ext_vector_type(4)));
typedef unsigned u32x4 __attribute__((ext_vector_type(4)));
constexpr int BM = 256, BK = 64, HALF = 128, HTB = HALF * BK * 2  , STAGE_BYTES = 8 * HTB, NXCD = 8, WGM = 8;

__host__ __device__ __forceinline__ int lds_byte(int r, int c) { const int st = (r >> 4) * 2 + (c >> 5), rr = r & 15, cc = c & 31, ob = rr * 64 + cc * 2; return st * 1024 + (ob ^ (((ob >> 9) & 1) << 5)); }
__host__ __device__ __forceinline__ void stage_rc(int b, int& R, int& C) { const int st = b / 1024, sb = b % 1024, swz = sb ^ (((sb >> 9) & 1) << 5); R = (st >> 1) * 16 + swz / 64; C = (st & 1) * 32 + (swz % 64) / 2; }
__host__ __device__ __forceinline__ int perm32(int rho) { const int n = rho >> 4, i = rho & 15; return 8 * (i >> 2) + 4 * n + (i & 3); }

struct Unit { int pm, pn; };
struct Gemm { const bf16_t* A; const bf16_t* Bt; int M, N, K; };

struct StaticOrder {
    int nM, nN, nwg, G, c;
    __host__ __device__ void init(int M, int N, int G_, int c_) { nM = M / BM; nN = N / BM; nwg = nM * nN; G = G_; c = c_; }
    __host__ __device__ bool next(int i, Unit& u) const {
        const long L = (long)i * G + c; if (L >= nwg) return false;
        int wgid = (int)L; { const int q = nwg / NXCD, r = nwg % NXCD, xcd = wgid % NXCD, off = wgid / NXCD; wgid = (xcd < r ? xcd * (q + 1) : r * (q + 1) + (xcd - r) * q) + off; }
        const int nig = WGM * nN, gid = wgid / nig, fm = gid * WGM, gsz = (nM - fm) < WGM ? (nM - fm) : WGM;
        u.pm = fm + ((wgid % nig) % gsz); u.pn = (wgid % nig) / gsz; return true;
    }
    __device__ __forceinline__ void a_ready(const Unit&) const {}
    __device__ __forceinline__ void done(const Unit&) const {}
};

__device__ __forceinline__ unsigned cvt_pk_bf16(float lo, float hi) { unsigned r; asm volatile("v_cvt_pk_bf16_f32 %0, %1, %2" : "=v"(r) : "v"(lo), "v"(hi)); return r; }
template <class Epi, class Sched, bool ALIGN_EPI = false, bool SP2 = false>
__device__ __forceinline__ void gemm_phase(PG8_LAS unsigned char* lds, const Gemm g, const Sched& S, const Epi& E) {
    const int tid = threadIdx.x, wid = __builtin_amdgcn_readfirstlane(tid >> 6), lane = tid & 63, wr = wid >> 2, wc = wid & 3, fr = lane & 15, fq = lane >> 4;
    const int K = g.K, nt = K / BK;
    unsigned voffA[2], voffB[2];
#pragma unroll
    for (int i = 0; i < 2; ++i) { int R, C; stage_rc(tid * 16 + i * 8192, R, C); const int Rb = Epi::PERM ? ((R & ~31) + perm32(R & 31)) : R;
        voffA[i] = (unsigned)(R * K + C) * 2u; voffB[i] = (unsigned)(Rb * K + C) * 2u; }
    const size_t kstep = (size_t)(BK * 2);
    const size_t hstep = (size_t)HALF * K * 2;
    const size_t tstep = 2 * hstep;
    const unsigned ldsw = (unsigned)wid * 1024u;
    const int aoff = lds_byte(wr * 64 + fr, fq * 8), boff = lds_byte(wc * 32 + fr, fq * 8);
#define PG8_SA(b, h) (((b) * 2 + (h)) * HTB)
#define PG8_SB(b, h) ((4 + (b) * 2 + (h)) * HTB)
#define PG8_STAGE(bufoff, gbase, voff) do { _Pragma("unroll") for (int _i = 0; _i < 2; ++_i) \
        __builtin_amdgcn_global_load_lds((const unsigned*)((const char*)(gbase) + (voff)[_i]), (PG8_LAS unsigned*)(lds + (bufoff) + ldsw + _i * 8192), 16, 0, 0); } while (0)
#define PG8_LDA(dst, b, h) do { _Pragma("unroll") for (int m = 0; m < 4; ++m) _Pragma("unroll") for (int k = 0; k < 2; ++k) dst[m][k] = *(const PG8_LAS bf16x8*)(lds + PG8_SA(b, h) + aoff + m * 2048 + k * 1024); } while (0)
#define PG8_LDB(dst, b, h) do { _Pragma("unroll") for (int n = 0; n < 2; ++n) _Pragma("unroll") for (int k = 0; k < 2; ++k) dst[n][k] = *(const PG8_LAS bf16x8*)(lds + PG8_SB(b, h) + boff + n * 2048 + k * 1024); } while (0)
#define PG8_MMA(ai, bj, At, Bt) do { __builtin_amdgcn_s_setprio(1); _Pragma("unroll") for (int m = 0; m < 4; ++m) _Pragma("unroll") for (int n = 0; n < 2; ++n) _Pragma("unroll") for (int k = 0; k < 2; ++k) \
        acc[ai][bj][m][n] = __builtin_amdgcn_mfma_f32_16x16x32_bf16(Bt[n][k], At[m][k], acc[ai][bj][m][n], 0, 0, 0); __builtin_amdgcn_s_setprio(0); } while (0)
#define PG8_WAIT_V(n) asm volatile("s_waitcnt vmcnt(" #n ")" ::: "memory")
#define PG8_WAIT_L(n) asm volatile("s_waitcnt lgkmcnt(" #n ")" ::: "memory")
#define PG8_BAR __builtin_amdgcn_s_barrier()
#define PG8_SCHED __builtin_amdgcn_sched_barrier(0)
    Unit cur, nxt; int ui = 0;
    if (!S.next(0, cur)) return;
    f32x4 acc[2][2][4][2];
#pragma unroll
    for (int a = 0; a < 2; ++a)
#pragma unroll
        for (int b = 0; b < 2; ++b)
#pragma unroll
            for (int m = 0; m < 4; ++m)
#pragma unroll
                for (int n = 0; n < 2; ++n) acc[a][b][m][n] = (f32x4){0.f, 0.f, 0.f, 0.f};
    bf16x8 At[4][2], B0[2][2], B1[2][2];
    const char* cA = (const char*)g.A + (size_t)cur.pm * tstep; const char* cB = (const char*)g.Bt + (size_t)cur.pn * tstep;
    S.a_ready(cur);
    if constexpr (SP2) {
        PG8_STAGE(PG8_SB(0, 0), cB, voffB); PG8_STAGE(PG8_SB(0, 1), cB + hstep, voffB); PG8_STAGE(PG8_SA(0, 0), cA, voffA); PG8_STAGE(PG8_SA(0, 1), cA + hstep, voffA);
        if (wr == 1) PG8_BAR;
        PG8_WAIT_V(2); PG8_BAR;
        PG8_STAGE(PG8_SB(1, 0), cB + kstep, voffB); PG8_STAGE(PG8_SA(1, 0), cA + kstep, voffA); PG8_STAGE(PG8_SB(1, 1), cB + hstep + kstep, voffB);
        PG8_WAIT_V(6); PG8_BAR;
    } else {
        PG8_STAGE(PG8_SB(0, 0), cB, voffB); PG8_STAGE(PG8_SA(0, 0), cA, voffA); PG8_STAGE(PG8_SB(0, 1), cB + hstep, voffB); PG8_STAGE(PG8_SA(0, 1), cA + hstep, voffA);
        if (wr == 1) PG8_BAR;
        PG8_WAIT_V(4); PG8_BAR;
        PG8_STAGE(PG8_SB(1, 0), cB + kstep, voffB); PG8_STAGE(PG8_SA(1, 0), cA + kstep, voffA); PG8_STAGE(PG8_SB(1, 1), cB + hstep + kstep, voffB);
        PG8_WAIT_V(6); PG8_BAR;
    }
    for (;;) {
        const bool has_next = S.next(ui + 1, nxt);
        const char* nA = has_next ? (const char*)g.A + (size_t)nxt.pm * tstep : cA; const char* nB = has_next ? (const char*)g.Bt + (size_t)nxt.pn * tstep : cB;
        for (int t = 0; t < nt; t += 2) {
            const bool last = (t == nt - 2);
            const char* a1 = cA + (size_t)(t + 1) * kstep;
            const char* a2 = last ? nA : cA + (size_t)(t + 2) * kstep; const char* b2 = last ? nB : cB + (size_t)(t + 2) * kstep;
            const char* a3 = a2 + kstep; const char* b3 = b2 + kstep;
            if (last && has_next) S.a_ready(nxt);
            if constexpr (SP2) {
            PG8_LDB(B0, 0, 0); PG8_LDB(B1, 0, 1); PG8_SCHED; PG8_LDA(At, 0, 0); PG8_STAGE(PG8_SA(1, 1), a1 + hstep, voffA);
            PG8_WAIT_V(8); PG8_WAIT_L(0); PG8_BAR; PG8_MMA(0, 0, At, B0); PG8_MMA(0, 1, At, B1); PG8_BAR; PG8_SCHED;
            PG8_LDA(At, 0, 1); PG8_STAGE(PG8_SB(0, 0), b2, voffB); PG8_STAGE(PG8_SB(0, 1), b2 + hstep, voffB); PG8_STAGE(PG8_SA(0, 0), a2, voffA);
            PG8_WAIT_V(8); PG8_WAIT_L(0); PG8_BAR; PG8_MMA(1, 0, At, B0); PG8_MMA(1, 1, At, B1); PG8_BAR; PG8_SCHED;
            PG8_LDB(B0, 1, 0); PG8_LDB(B1, 1, 1); PG8_SCHED; PG8_LDA(At, 1, 0); PG8_STAGE(PG8_SA(0, 1), a2 + hstep, voffA);
            PG8_WAIT_V(8); PG8_WAIT_L(0); PG8_BAR; PG8_MMA(0, 0, At, B0); PG8_MMA(0, 1, At, B1); PG8_BAR; PG8_SCHED;
            PG8_LDA(At, 1, 1); PG8_STAGE(PG8_SB(1, 0), b3, voffB); PG8_STAGE(PG8_SB(1, 1), b3 + hstep, voffB); PG8_STAGE(PG8_SA(1, 0), a3, voffA);
            PG8_WAIT_V(8); PG8_WAIT_L(0); PG8_BAR; PG8_MMA(1, 0, At, B0); PG8_MMA(1, 1, At, B1); PG8_BAR; PG8_SCHED;
            } else {
            PG8_LDB(B0, 0, 0); PG8_SCHED; PG8_LDA(At, 0, 0); PG8_STAGE(PG8_SA(1, 1), a1 + hstep, voffA);
            PG8_WAIT_L(8); PG8_BAR; PG8_WAIT_L(0); PG8_MMA(0, 0, At, B0); PG8_BAR; PG8_SCHED;
            PG8_LDB(B1, 0, 1); PG8_STAGE(PG8_SB(0, 0), b2, voffB);
            PG8_BAR; PG8_WAIT_L(0); PG8_MMA(0, 1, At, B1); PG8_BAR;
            PG8_LDA(At, 0, 1); PG8_STAGE(PG8_SA(0, 0), a2, voffA);
            PG8_BAR; PG8_WAIT_L(0); PG8_MMA(1, 0, At, B0); PG8_BAR; PG8_SCHED;
            PG8_STAGE(PG8_SB(0, 1), b2 + hstep, voffB);
            PG8_WAIT_V(6); PG8_BAR; PG8_MMA(1, 1, At, B1); PG8_BAR;
            PG8_LDB(B0, 1, 0); PG8_SCHED; PG8_LDA(At, 1, 0); PG8_STAGE(PG8_SA(0, 1), a2 + hstep, voffA);
            PG8_WAIT_L(8); PG8_BAR; PG8_WAIT_L(0); PG8_MMA(0, 0, At, B0); PG8_BAR; PG8_SCHED;
            PG8_LDB(B1, 1, 1); PG8_STAGE(PG8_SB(1, 0), b3, voffB);
            PG8_BAR; PG8_WAIT_L(0); PG8_MMA(0, 1, At, B1); PG8_BAR;
            PG8_LDA(At, 1, 1); PG8_STAGE(PG8_SA(1, 0), a3, voffA);
            PG8_BAR; PG8_WAIT_L(0); PG8_MMA(1, 0, At, B0); PG8_BAR; PG8_SCHED;
            PG8_STAGE(PG8_SB(1, 1), b3 + hstep, voffB);
            PG8_WAIT_V(6); PG8_BAR; PG8_MMA(1, 1, At, B1); PG8_BAR;
            }
        }
        if constexpr (ALIGN_EPI) { if (wr == 0) PG8_BAR; }
        if constexpr (!Epi::AFTER_DRAIN) { E(acc, cur, wr, wc, fr, fq); S.done(cur); }
        if (!has_next) break;
#pragma unroll
        for (int a = 0; a < 2; ++a)
#pragma unroll
            for (int b = 0; b < 2; ++b)
#pragma unroll
                for (int m = 0; m < 4; ++m)
#pragma unroll
                    for (int n = 0; n < 2; ++n) acc[a][b][m][n] = (f32x4){0.f, 0.f, 0.f, 0.f};
        cur = nxt; cA = nA; cB = nB; ++ui;
        if constexpr (ALIGN_EPI) { if (wr == 1) PG8_BAR; }
    }
    PG8_WAIT_V(0);
    if constexpr (!ALIGN_EPI) { if (wr == 0) PG8_BAR; }
    PG8_BAR;
    if constexpr (Epi::AFTER_DRAIN) { E.fused(acc, cur, wr, wc, fr, fq, lds, wid, lane); S.done(cur); }
#undef PG8_SA
#undef PG8_SB
#undef PG8_STAGE
#undef PG8_LDA
#undef PG8_LDB
#undef PG8_MMA
#undef PG8_WAIT_V
#undef PG8_WAIT_L
#undef PG8_BAR
#undef PG8_SCHED
}
}
#define LAS __attribute__((address_space(3)))
typedef unsigned short bf16_t;
typedef short bf16x8 __attribute__((ext_vector_type(8)));
typedef short s16x4 __attribute__((ext_vector_type(4)));
typedef float f32x4 __attribute__((ext_vector_type(4)));
typedef float f32x2 __attribute__((ext_vector_type(2)));
typedef float f32x16 __attribute__((ext_vector_type(16)));
typedef unsigned u32x4 __attribute__((ext_vector_type(4)));
typedef unsigned u32x2 __attribute__((ext_vector_type(2)));
typedef __bf16 bf16x2_t __attribute__((ext_vector_type(2)));

constexpr int NWAVES = 8, NTHR = 512;
constexpr int M_ = 32768, SEQ = 8192, DM = 1024, NIN = 4608, DFF = 4096, CCH = 512, PLED = 256, NHEAD = 4;
constexpr int ZQ = 1024, ZK = 1536, ZV = 2048, ZGC = 2560, ZGA = 3584;
constexpr float LOG2E = 1.4426950408889634f;
constexpr float QSCALE = 0.125f * LOG2E;
constexpr float ALPHA = 1.189207115002721f;
constexpr float EPS = 1e-5f;
constexpr float LAMBDA_INIT = 0.2f;
constexpr int LDS_BYTES = 155648;

constexpr size_t MiB = 1u << 20;
constexpr size_t WS_Z = 0;
constexpr size_t WS_WIN = 288 * MiB;
constexpr size_t WS_WFF1 = 297 * MiB;
constexpr size_t WS_WFF2 = 307 * MiB;
constexpr size_t WS_WO = 315 * MiB;
constexpr size_t WS_WC = 317 * MiB;
constexpr size_t WS_WA = 318 * MiB;
constexpr size_t WS_WPLE = 319 * MiB;
constexpr size_t WS_ST0 = 320 * MiB;
constexpr size_t WS_ST1 = 321 * MiB;
constexpr size_t WS_CTL = 320 * MiB + 512 * 1024;
constexpr size_t WS_HB = 322 * MiB;
constexpr size_t WS_PE = 386 * MiB;
constexpr size_t WS_PB = 450 * MiB;
constexpr size_t WS_END = 466 * MiB;

__device__ __forceinline__ unsigned cvtpk(float lo, float hi) { f32x2 v = {lo, hi}; bf16x2_t b = __builtin_convertvector(v, bf16x2_t); return __builtin_bit_cast(unsigned, b); }
__device__ __forceinline__ float bflo(unsigned w) { return __uint_as_float(w << 16); }
__device__ __forceinline__ float bfhi(unsigned w) { return __uint_as_float(w & 0xffff0000u); }
__device__ __forceinline__ float sigm(float x) { return __builtin_amdgcn_rcpf(1.f + __builtin_amdgcn_exp2f(-x * LOG2E)); }
__device__ __forceinline__ float wave_sum(float v) {
#pragma unroll
    for (int o = 1; o < 64; o <<= 1) v += __shfl_xor(v, o);
    return v;
}
__device__ __forceinline__ void unpack8(const u32x4 w, f32x4& a, f32x4& b) {
    a = (f32x4){bflo(w.x), bfhi(w.x), bflo(w.y), bfhi(w.y)}; b = (f32x4){bflo(w.z), bfhi(w.z), bflo(w.w), bfhi(w.w)};
}
__device__ __forceinline__ u32x4 pack8(const f32x4 a, const f32x4 b) {
    u32x4 w; w.x = cvtpk(a[0], a[1]); w.y = cvtpk(a[2], a[3]); w.z = cvtpk(b[0], b[1]); w.w = cvtpk(b[2], b[3]); return w;
}

using pg8::Unit;
struct EpiZ {
    static constexpr bool PERM = true, AFTER_DRAIN = false;
    bf16_t* O; int ldc; int kind; unsigned* KM;
    __device__ __forceinline__ void operator()(const f32x4 (&acc)[2][2][4][2], const Unit& u, int wr, int wc, int fr, int fq) const {
        const int row0 = u.pm * 256 + wr * 64 + fr, col0 = u.pn * 256 + wc * 32 + 8 * fq;
        int mode = 0; if (kind == 0) mode = (u.pn == 4 || u.pn == 5) ? 1 : (u.pn >= 10 ? 2 : (u.pn == 6 || u.pn == 7) ? 3 : 0);
        float mx[2] = {0.f, 0.f};
#pragma unroll
        for (int ai = 0; ai < 2; ++ai)
#pragma unroll
            for (int m = 0; m < 4; ++m) { bf16_t* rowp = O + (size_t)(row0 + ai * 128 + m * 16) * ldc + col0;
#pragma unroll
                for (int bj = 0; bj < 2; ++bj) { f32x4 v0 = acc[ai][bj][m][0], v1 = acc[ai][bj][m][1];
                    if (mode == 1) { v0 = v0 * QSCALE; v1 = v1 * QSCALE; }
                    else if (mode == 2) {
#pragma unroll
                        for (int e = 0; e < 4; ++e) { v0[e] = sigm(v0[e]); v1[e] = sigm(v1[e]); } }
                    else if (mode == 3) {
                        float ss = (v0[0] * v0[0] + v0[1] * v0[1]) + (v0[2] * v0[2] + v0[3] * v0[3]) + (v1[0] * v1[0] + v1[1] * v1[1]) + (v1[2] * v1[2] + v1[3] * v1[3]);
                        ss += __shfl_xor(ss, 16); ss += __shfl_xor(ss, 32); mx[bj] = fmaxf(mx[bj], ss); }
                    *(u32x4*)(rowp + bj * 128) = pack8(v0, v1); } }
        if (mode == 3) {
#pragma unroll
            for (int bj = 0; bj < 2; ++bj) { float v = mx[bj];
#pragma unroll
                for (int o = 1; o < 16; o <<= 1) v = fmaxf(v, __shfl_xor(v, o));
                if (fr == 0 && fq == 0) atomicMax(KM + ((((u.pm >> 5) * 4 + (u.pn - 6) * 2 + bj) * 2 + (wc >> 1)) * 2 + (wc & 1)), __float_as_uint(v)); }
        }
    }
};
struct EpiGate {
    static constexpr bool PERM = true, AFTER_DRAIN = false;
    bf16_t* MG; const bf16_t* Z; int gcol; int add;
    __device__ __forceinline__ void operator()(const f32x4 (&acc)[2][2][4][2], const Unit& u, int wr, int wc, int fr, int fq) const {
        const int row0 = u.pm * 256 + wr * 64 + fr, col0 = u.pn * 256 + wc * 32 + 8 * fq;
#pragma unroll
        for (int ai = 0; ai < 2; ++ai)
#pragma unroll
            for (int m = 0; m < 4; ++m) { const size_t row = (size_t)(row0 + ai * 128 + m * 16);
#pragma unroll
                for (int bj = 0; bj < 2; ++bj) { const int col = col0 + bj * 128;
                    const u32x4 gw = *(const u32x4*)(Z + row * NIN + gcol + col); f32x4 g0, g1; unpack8(gw, g0, g1);
                    f32x4 v0 = acc[ai][bj][m][0] * g0, v1 = acc[ai][bj][m][1] * g1;
                    bf16_t* dst = MG + row * DM + col;
                    if (add) { const u32x4 pw = *(const u32x4*)dst; f32x4 p0, p1; unpack8(pw, p0, p1); v0 = v0 + p0; v1 = v1 + p1; }
                    *(u32x4*)dst = pack8(v0, v1); } }
    }
};
struct EpiRes {
    static constexpr bool PERM = false, AFTER_DRAIN = false;
    const float* src; const float* st; const float* g; const float* b; const bf16_t* ple; float* out;
    __device__ __forceinline__ void operator()(const f32x4 (&acc)[2][2][4][2], const Unit& u, int wr, int wc, int fr, int fq) const {
        const int row0 = u.pm * 256 + wr * 64 + fr, col0 = u.pn * 256 + wc * 32 + 4 * fq;
#pragma unroll
        for (int ai = 0; ai < 2; ++ai)
#pragma unroll
            for (int m = 0; m < 4; ++m) { const size_t row = (size_t)(row0 + ai * 128 + m * 16); const f32x2 s = *(const f32x2*)(st + row * 2);
#pragma unroll
                for (int bj = 0; bj < 2; ++bj)
#pragma unroll
                    for (int n = 0; n < 2; ++n) { const int col = col0 + bj * 128 + n * 16;
                        const f32x4 xv = *(const f32x4*)(src + row * DM + col); const f32x4 gv = *(const f32x4*)(g + col), bv = *(const f32x4*)(b + col);
                        f32x4 o = ((xv - s.x) * s.y * gv + bv) * ALPHA + acc[ai][bj][m][n];
                        if (ple) { const u32x2 pw = *(const u32x2*)(ple + row * DM + col); o = o + (f32x4){bflo(pw.x), bfhi(pw.x), bflo(pw.y), bfhi(pw.y)}; }
                        *(f32x4*)(out + row * DM + col) = o; }
                asm volatile("" ::: "memory"); }
    }
};
struct EpiFF1 {
    static constexpr bool PERM = true, AFTER_DRAIN = false;
    bf16_t* FF1; bf16_t* PE;
    __device__ __forceinline__ void operator()(const f32x4 (&acc)[2][2][4][2], const Unit& u, int wr, int wc, int fr, int fq) const {
        const int row0 = u.pm * 256 + wr * 64 + fr;
        if (u.pn < 16) {
            const int col0 = u.pn * 256 + wc * 32 + 8 * fq;
#pragma unroll
            for (int ai = 0; ai < 2; ++ai)
#pragma unroll
                for (int m = 0; m < 4; ++m) { bf16_t* rowp = FF1 + (size_t)(row0 + ai * 128 + m * 16) * DFF + col0;
#pragma unroll
                    for (int bj = 0; bj < 2; ++bj) { f32x4 v0 = acc[ai][bj][m][0], v1 = acc[ai][bj][m][1];
#pragma unroll
                        for (int e = 0; e < 4; ++e) { const float a = fmaxf(v0[e], 0.f), c = fmaxf(v1[e], 0.f); v0[e] = a * a; v1[e] = c * c; }
                        *(u32x4*)(rowp + bj * 128) = pack8(v0, v1); } }
        } else {
            const int col0 = (u.pn - 16) * 256 + wc * 32 + 8 * fq;
#pragma unroll
            for (int ai = 0; ai < 2; ++ai)
#pragma unroll
                for (int m = 0; m < 4; ++m) { bf16_t* rowp = PE + (size_t)(row0 + ai * 128 + m * 16) * DM + col0;
#pragma unroll
                    for (int bj = 0; bj < 2; ++bj) { f32x4 v0 = acc[ai][bj][m][0], v1 = acc[ai][bj][m][1];
                        const u32x4 pw = *(const u32x4*)(rowp + bj * 128); f32x4 p0, p1; unpack8(pw, p0, p1);
#pragma unroll
                        for (int e = 0; e < 4; ++e) { v0[e] = sigm(v0[e]) * p0[e]; v1[e] = sigm(v1[e]) * p1[e]; }
                        *(u32x4*)(rowp + bj * 128) = pack8(v0, v1); } }
        }
    }
};

__device__ __forceinline__ unsigned f2bf(float f) { unsigned u = __float_as_uint(f); return (u + 0x7fffu + ((u >> 16) & 1u)) >> 16; }
__device__ __forceinline__ unsigned pk2(float lo, float hi) { return f2bf(lo) | (f2bf(hi) << 16); }
__device__ __forceinline__ void transpose_item(const float* W, int K, int N, bf16_t* WT, int row_off, LAS float* scr, int item, int lane) {
    const int nblk = N / 32, kb = item / nblk, nb = item % nblk, k0 = 64 * kb, n0 = 32 * nb;
#pragma unroll 8
    for (int i = 0; i < 32; ++i) { const int kk = 2 * i + (lane >> 5); scr[kk * 33 + (lane & 31)] = W[(size_t)(k0 + kk) * N + n0 + (lane & 31)]; }
    asm volatile("s_waitcnt lgkmcnt(0)" ::: "memory");
    const int c = lane & 7;
#pragma unroll
    for (int j = 0; j < 4; ++j) { const int n = (lane >> 3) + 8 * j; const LAS float* s = scr + (8 * c) * 33 + n;
        u32x4 o; o.x = pk2(s[0 * 33], s[1 * 33]); o.y = pk2(s[2 * 33], s[3 * 33]); o.z = pk2(s[4 * 33], s[5 * 33]); o.w = pk2(s[6 * 33], s[7 * 33]);
        *(u32x4*)(WT + (size_t)(row_off + n0 + n) * K + k0 + 8 * c) = o; }
    asm volatile("s_waitcnt lgkmcnt(0)" ::: "memory");
}
template <int MODE> __device__ __forceinline__ void ln_rows(const float* src, bf16_t* dstb, float* dstf, float* st, const float* g, const float* b, int gw, int ngw, int lane) {
    f32x4 gv[4], bv[4];
#pragma unroll
    for (int j = 0; j < 4; ++j) { gv[j] = *((const f32x4*)g + lane + 64 * j); bv[j] = *((const f32x4*)b + lane + 64 * j); }
    for (int row = gw; row < M_; row += ngw) {
        const f32x4* xr = (const f32x4*)(src + (size_t)row * DM) + lane;
        f32x4 v[4]; float s = 0.f;
#pragma unroll
        for (int j = 0; j < 4; ++j) { v[j] = xr[64 * j]; s += (v[j][0] + v[j][1]) + (v[j][2] + v[j][3]); }
        const float mean = wave_sum(s) * (1.f / DM); float s2 = 0.f;
#pragma unroll
        for (int j = 0; j < 4; ++j) { v[j] = v[j] - mean; s2 += (v[j][0] * v[j][0] + v[j][1] * v[j][1]) + (v[j][2] * v[j][2] + v[j][3] * v[j][3]); }
        const float rstd = 1.f / sqrtf(wave_sum(s2) * (1.f / DM) + EPS);
        if (MODE == 0) {
            u32x2* o8 = (u32x2*)(dstb + (size_t)row * DM) + lane;
#pragma unroll
            for (int j = 0; j < 4; ++j) { const f32x4 y = v[j] * rstd * gv[j] + bv[j]; u32x2 w; w.x = cvtpk(y[0], y[1]); w.y = cvtpk(y[2], y[3]); o8[64 * j] = w; }
            if (lane == 0) *(f32x2*)(st + (size_t)row * 2) = (f32x2){mean, rstd};
        } else {
            f32x4* o = (f32x4*)(dstf + (size_t)row * DM) + lane;
#pragma unroll
            for (int j = 0; j < 4; ++j) o[64 * j] = v[j] * rstd * gv[j] + bv[j];
        }
    }
}

__device__ __forceinline__ void conv_unit(LAS unsigned char* lds, const bf16_t* Z, bf16_t* UC, const float* cw, const float* lg, const float* lb, int unit) {
    const int tid = threadIdx.x, lane = tid & 63, wid = tid >> 6;
    const int m0 = unit * 32, s0 = m0 % SEQ;
    float w[31];
#pragma unroll
    for (int k = 0; k < 31; ++k) w[k] = cw[k * CCH + tid];
    float uw[62];
#pragma unroll
    for (int i = 0; i < 62; ++i) {
        const bool ok = (s0 - 30 + i >= 0);
        const bf16_t* zp = Z + (size_t)(ok ? m0 - 30 + i : m0) * NIN + tid;
        const float a = __uint_as_float((unsigned)zp[0] << 16), gg = __uint_as_float((unsigned)zp[CCH] << 16);
        uw[i] = ok ? a * sigm(gg) : 0.f;
    }
    LAS float* yl = (LAS float*)lds;
#pragma unroll
    for (int j = 0; j < 32; ++j) { float y = 0.f;
#pragma unroll
        for (int k = 0; k < 31; ++k) y += w[k] * uw[j + k];
        yl[j * CCH + tid] = y; }
    __syncthreads();
#pragma unroll
    for (int rr = 0; rr < 4; ++rr) { const int row = wid * 4 + rr;
        f32x4 v[2]; float s = 0.f;
#pragma unroll
        for (int i = 0; i < 2; ++i) { v[i] = *(const LAS f32x4*)(yl + row * CCH + lane * 4 + 256 * i); s += (v[i][0] + v[i][1]) + (v[i][2] + v[i][3]); }
        const float mean = wave_sum(s) * (1.f / CCH); float s2 = 0.f;
#pragma unroll
        for (int i = 0; i < 2; ++i) { v[i] = v[i] - mean; s2 += (v[i][0] * v[i][0] + v[i][1] * v[i][1]) + (v[i][2] * v[i][2] + v[i][3] * v[i][3]); }
        const float rstd = 1.f / sqrtf(wave_sum(s2) * (1.f / CCH) + EPS);
#pragma unroll
        for (int i = 0; i < 2; ++i) { const int col = lane * 4 + 256 * i; const f32x4 gv = *(const f32x4*)(lg + col), bv = *(const f32x4*)(lb + col);
            f32x4 y = v[i] * rstd * gv + bv;
#pragma unroll
            for (int e = 0; e < 4; ++e) y[e] = y[e] * sigm(y[e]);
            u32x2 o; o.x = cvtpk(y[0], y[1]); o.y = cvtpk(y[2], y[3]); *(u32x2*)(UC + (size_t)(m0 + row) * CCH + col) = o; }
    }
    __syncthreads();
}

constexpr int A_KSTR = 128, A_VSTR = 256, A_KB = 64 * A_KSTR, A_VB = 64 * A_VSTR, A_KSLOT = 2 * A_KB, A_VBASE3 = 3 * A_KSLOT, A_SCR = A_VBASE3 + 4 * A_VB, A_QF = A_SCR + 2048;
__device__ __forceinline__ void glds16(const void* gsrc, unsigned lds_dst) { unsigned keep;
    asm volatile("s_mov_b32 %0, m0\n\ts_mov_b32 m0, %2\n\ts_nop 0\n\tglobal_load_lds_dwordx4 %1, off\n\ts_mov_b32 m0, %0" : "=&s"(keep) : "v"(gsrc), "s"(lds_dst) : "memory"); }
#define A_WAIT_BAR(N) asm volatile("s_waitcnt vmcnt(" #N ") lgkmcnt(0)\n\ts_barrier" ::: "memory")
__device__ __forceinline__ float max3f(float a, float b, float c) { float r; asm("v_max3_f32 %0, %1, %2, %3" : "=v"(r) : "v"(a), "v"(b), "v"(c)); return r; }
__device__ __forceinline__ int crow(int r, int hi) { return (r & 3) + 8 * (r >> 2) + 4 * hi; }
__device__ __forceinline__ s16x4 vtr(const LAS unsigned char* p) { return __builtin_bit_cast(s16x4, __builtin_amdgcn_ds_read_tr16_b64_v4i16((LAS s16x4*)p)); }

__device__ __forceinline__ void attn_unit(LAS unsigned char* lds, const bf16_t* Z, bf16_t* OA, const float* subg, const unsigned* KM, int b, int h, int qb, float lam) {
    const int tid = threadIdx.x, lane = tid & 63, r32 = lane & 31, hi = lane >> 5;
    const int wid = __builtin_amdgcn_readfirstlane(tid >> 6), team = wid >> 2, rg = (wid >> 1) & 1 | (team << 1), c = wid & 1;
    const size_t brow0 = (size_t)b * SEQ;
    const int q0 = qb * 128, qpos = q0 + 32 * rg + r32;
    const float slope2 = __builtin_amdgcn_exp2f(-2.f * (float)(h + 1)) * LOG2E;
    bf16x8 qf[4];
    { const bf16_t* qp = Z + (brow0 + qpos) * NIN + ZQ + h * 128 + c * 64 + hi * 8;
#pragma unroll
      for (int s = 0; s < 4; ++s) qf[s] = *(const bf16x8*)(qp + 16 * s); }
    int ksrc, vsrc0;
    { const int kk = 8 * wid + (lane >> 3); ksrc = kk * NIN + ZK + h * 128 + (((lane & 7) ^ ((kk >> 1) & 7)) << 3);
      const int kv = 8 * wid + (lane >> 4); vsrc0 = kv * NIN + ZV + h * 128 + (((lane & 15) ^ (4 * (kv & 3))) << 3); }
    const bf16_t* zb = Z + brow0 * NIN;
    const unsigned lds0 = (unsigned)(uintptr_t)lds;
#define A_DMA(t, ko, vo) do { const bf16_t* p_ = zb + (size_t)(64 * (t)) * NIN; \
        glds16(p_ + ksrc, (unsigned)__builtin_amdgcn_readfirstlane(lds0 + (ko) + wid * 1024)); \
        glds16(p_ + ksrc + 64, (unsigned)__builtin_amdgcn_readfirstlane(lds0 + (ko) + A_KB + wid * 1024)); \
        glds16(p_ + vsrc0, (unsigned)__builtin_amdgcn_readfirstlane(lds0 + (vo) + wid * 2048)); \
        glds16(p_ + vsrc0 + 4 * NIN, (unsigned)__builtin_amdgcn_readfirstlane(lds0 + (vo) + wid * 2048 + 1024)); } while (0)
    const int nt = 2 * (qb + 1);
    LAS float* wscr = (LAS float*)(lds + A_SCR) + wid * 32;
    const int kx = (r32 >> 1) & 7;
    const int koff = c * A_KB + r32 * A_KSTR + ((hi ^ (kx & 1)) << 4), ksx = kx >> 1;
    const int vq = (lane & 15) >> 2;
    const int voff = A_VBASE3 + (4 * hi + vq) * A_VSTR + ((lane >> 4) & 1) * 32 + (lane & 3) * 8;
    f32x16 O[4];
#pragma unroll
    for (int d = 0; d < 4; ++d)
#pragma unroll
        for (int r = 0; r < 16; ++r) O[d][r] = 0.f;
    float mrun, lrun = 0.f; int t_lo;
    { const bf16_t* kp = Z + (brow0 + qpos) * NIN + ZK + h * 128 + c * 64 + hi * 8;
      float qa = 0.f, qbn = 0.f, dot = 0.f;
#pragma unroll
      for (int s = 0; s < 4; ++s) { const bf16x8 kd = *(const bf16x8*)(kp + 16 * s);
#pragma unroll
          for (int e = 0; e < 8; ++e) { const float qv = __uint_as_float((unsigned)(unsigned short)qf[s][e] << 16), kv = __uint_as_float((unsigned)(unsigned short)kd[e] << 16);
              if (s < 2) qa += qv * qv; else qbn += qv * qv; dot += qv * kv; } }
      qa += __shfl_xor(qa, 32); qbn += __shfl_xor(qbn, 32); dot += __shfl_xor(dot, 32);
      const unsigned* km = KM + ((b * 4 + h) * 2 + c) * 2;
      const float kma = sqrtf(__uint_as_float(km[0])), kmb = sqrtf(__uint_as_float(km[1]));
      const float bnum = (sqrtf(qa) * kma + sqrtf(qbn) * kmb) * 1.01f - dot + 40.f;
      float kmin = (float)qpos - bnum / slope2;
#pragma unroll
      for (int o = 1; o < 64; o <<= 1) kmin = fminf(kmin, __shfl_xor(kmin, o));
      if (lane == 0) ((LAS float*)(lds + A_SCR + 1024))[wid] = kmin;
      mrun = dot; }
    int ks_cur = (nt - 1) % 3, vs_cur = (nt - 1) & 3;
    asm volatile("s_waitcnt vmcnt(0)" ::: "memory");
    A_DMA(nt - 1, ks_cur * A_KSLOT, A_VBASE3 + vs_cur * A_VB);
    A_DMA(nt - 2, ((ks_cur + 2) % 3) * A_KSLOT, A_VBASE3 + ((vs_cur + 3) & 3) * A_VB);
    A_WAIT_BAR(4);
    { float kmin = ((LAS float*)(lds + A_SCR + 1024))[0];
#pragma unroll
      for (int w = 1; w < 8; ++w) kmin = fminf(kmin, ((LAS float*)(lds + A_SCR + 1024))[w]);
      t_lo = kmin <= 0.f ? 0 : (int)(kmin * (1.f / 64.f)); if (t_lo > nt - 1) t_lo = nt - 1; t_lo = __builtin_amdgcn_readfirstlane(t_lo); }
    const LAS unsigned char* qfl = lds + A_QF + wid * 4096 + lane * 16;
#pragma unroll
    for (int s = 0; s < 4; ++s) *(LAS bf16x8*)(lds + A_QF + wid * 4096 + lane * 16 + s * 1024) = qf[s];
    const int t_first = (64 * (nt - 1) > q0 + 32 * rg + 31) ? nt - 2 : nt - 1;
    bf16x8 pa[4];
#define A_QKSM(t) do { \
        const LAS unsigned char* Kb = lds + ks_cur * A_KSLOT + koff; \
        const float base = slope2 * (float)(64 * (t) + 4 * hi - qpos) - mrun, base1 = base + 32.f * slope2; \
        f32x16 S0, S1; \
        _Pragma("unroll") for (int r = 0; r < 16; ++r) { const float kr = (float)((r & 3) + 8 * (r >> 2)); S0[r] = __builtin_fmaf(slope2, kr, base); S1[r] = __builtin_fmaf(slope2, kr, base1); } \
        _Pragma("unroll") for (int sh = 0; sh < 2; ++sh) { bf16x8 k0[2], k1[2], qs[2]; \
          _Pragma("unroll") for (int s = 0; s < 2; ++s) { k0[s] = *(const LAS bf16x8*)(Kb + (((2 * sh + s) ^ ksx) << 5)); k1[s] = *(const LAS bf16x8*)(Kb + 32 * A_KSTR + (((2 * sh + s) ^ ksx) << 5)); qs[s] = *(const LAS bf16x8*)(qfl + (2 * sh + s) * 1024); } \
          __builtin_amdgcn_sched_barrier(0); \
          _Pragma("unroll") for (int s = 0; s < 2; ++s) { \
              S0 = __builtin_amdgcn_mfma_f32_32x32x16_bf16(k0[s], qs[s], S0, 0, 0, 0); \
              S1 = __builtin_amdgcn_mfma_f32_32x32x16_bf16(k1[s], qs[s], S1, 0, 0, 0); } \
          __builtin_amdgcn_sched_barrier(0); } \
        if ((t) >= nt - 2) { const int kb = 64 * ((t) - (nt - 2)), qrel = 32 * rg + r32; \
            _Pragma("unroll") for (int r = 0; r < 16; ++r) { const int kr = kb + crow(r, hi); if (kr > qrel) S0[r] = -1e30f; if (kr + 32 > qrel) S1[r] = -1e30f; } } \
        float rm = max3f(S0[0], S1[0], S0[1]), rm2 = max3f(S1[1], S0[2], S1[2]); \
        _Pragma("unroll") for (int r = 3; r < 15; r += 2) { rm = max3f(rm, S0[r], S1[r]); rm2 = max3f(rm2, S0[r + 1], S1[r + 1]); } \
        rm = max3f(rm, S0[15], S1[15]); rm = fmaxf(rm, rm2); \
        rm = fmaxf(rm, __shfl_xor(rm, 32)); \
        const bool need = rm > 8.f; \
        if (__any(need)) { \
            const float dl = need ? rm : 0.f; const float al = __builtin_amdgcn_exp2f(-dl); \
            lrun *= al; mrun += dl; \
            if (hi == 0) wscr[r32] = al; \
            _Pragma("unroll") for (int r = 0; r < 16; ++r) { const float a_ = wscr[crow(r, hi)]; S0[r] -= dl; S1[r] -= dl; \
                _Pragma("unroll") for (int d = 0; d < 4; ++d) O[d][r] *= a_; } } \
        f32x2 ls2 = {0.f, 0.f}; \
        _Pragma("unroll") for (int r = 0; r < 16; ++r) { S0[r] = __builtin_amdgcn_exp2f(S0[r]); S1[r] = __builtin_amdgcn_exp2f(S1[r]); ls2 += (f32x2){S0[r], S1[r]}; } \
        lrun += ls2.x + ls2.y; \
        { u32x4 w; \
          w.x = cvtpk(S0[0], S0[1]); w.y = cvtpk(S0[2], S0[3]); w.z = cvtpk(S0[4], S0[5]); w.w = cvtpk(S0[6], S0[7]); pa[0] = __builtin_bit_cast(bf16x8, w); \
          w.x = cvtpk(S0[8], S0[9]); w.y = cvtpk(S0[10], S0[11]); w.z = cvtpk(S0[12], S0[13]); w.w = cvtpk(S0[14], S0[15]); pa[1] = __builtin_bit_cast(bf16x8, w); \
          w.x = cvtpk(S1[0], S1[1]); w.y = cvtpk(S1[2], S1[3]); w.z = cvtpk(S1[4], S1[5]); w.w = cvtpk(S1[6], S1[7]); pa[2] = __builtin_bit_cast(bf16x8, w); \
          w.x = cvtpk(S1[8], S1[9]); w.y = cvtpk(S1[10], S1[11]); w.z = cvtpk(S1[12], S1[13]); w.w = cvtpk(S1[14], S1[15]); pa[3] = __builtin_bit_cast(bf16x8, w); } \
    } while (0)
#define A_VLD(dst, g) do { _Pragma("unroll") for (int k2 = 0; k2 < 2; ++k2) { const int d_ = 2 * ((g) >> 2) + k2, ks = (g) & 3; dst[2 * k2] = vtr(Vb + (16 * ks) * A_VSTR + ((d_ ^ vq) << 6)); dst[2 * k2 + 1] = vtr(Vb + (16 * ks + 8) * A_VSTR + ((d_ ^ vq) << 6)); } } while (0)
#define A_VMM(src, g) do { _Pragma("unroll") for (int k2 = 0; k2 < 2; ++k2) { const int d_ = 2 * ((g) >> 2) + k2; \
        const bf16x8 vf = __builtin_shufflevector(src[2 * k2], src[2 * k2 + 1], 0, 1, 2, 3, 4, 5, 6, 7); \
        O[d_] = __builtin_amdgcn_mfma_f32_32x32x16_bf16(pa[(g) & 3], vf, O[d_], 0, 0, 0); } } while (0)
#define A_PV(vslot) do { \
        const LAS unsigned char* Vb = lds + (vslot) * A_VB + voff; \
        s16x4 va[4], vb[4]; \
        A_VLD(va, 0); __builtin_amdgcn_sched_barrier(0); \
        A_VLD(vb, 1); A_VMM(va, 0); __builtin_amdgcn_sched_barrier(0); \
        A_VLD(va, 2); A_VMM(vb, 1); __builtin_amdgcn_sched_barrier(0); \
        A_VLD(vb, 3); A_VMM(va, 2); __builtin_amdgcn_sched_barrier(0); \
        A_VLD(va, 4); A_VMM(vb, 3); __builtin_amdgcn_sched_barrier(0); \
        A_VLD(vb, 5); A_VMM(va, 4); __builtin_amdgcn_sched_barrier(0); \
        A_VLD(va, 6); A_VMM(vb, 5); __builtin_amdgcn_sched_barrier(0); \
        A_VLD(vb, 7); A_VMM(va, 6); __builtin_amdgcn_sched_barrier(0); \
        A_VMM(vb, 7); __builtin_amdgcn_sched_barrier(0); \
    } while (0)
#define A_ITER_HEAD \
        const int ks_nxt = (ks_cur == 0) ? 2 : ks_cur - 1, vs_nxt = (vs_cur + 3) & 3, vs_prv = (vs_cur + 1) & 3;     \
        const bool pf = (t - 2 >= t_lo); \
        if (pf) A_DMA(t - 2, ((ks_cur + 1) % 3) * A_KSLOT, A_VBASE3 + ((vs_cur + 2) & 3) * A_VB);
#define A_ITER_TAIL \
        if (pf) A_WAIT_BAR(4); else A_WAIT_BAR(0);            \
        ks_cur = ks_nxt; vs_cur = vs_nxt; (void)vs_prv;
    if (team == 0) {
        for (int t = nt - 1; t >= t_lo - 1; --t) { A_ITER_HEAD
            if (t >= t_lo && t <= t_first) { A_QKSM(t); A_PV(vs_cur); }
            A_ITER_TAIL }
    } else {
        for (int t = nt - 1; t >= t_lo - 1; --t) { A_ITER_HEAD
            if (t + 1 <= t_first) A_PV(vs_prv);
            if (t >= t_lo && t <= t_first) A_QKSM(t);
            A_ITER_TAIL }
    }
#undef A_ITER_HEAD
#undef A_ITER_TAIL
#undef A_DMA
#undef A_QKSM
#undef A_PV
#undef A_VLD
#undef A_VMM
    int lane_e = lane; asm volatile("" : "+v"(lane_e));
    const int r32e = lane_e & 31, hie = lane_e >> 5;
    lrun += __shfl_xor(lrun, 32);
    { const float f = (c == 0 ? 1.f : -lam) / lrun;
      if (hie == 0) wscr[r32e] = f;
#pragma unroll
      for (int r = 0; r < 16; ++r) { const float a = wscr[crow(r, hie)];
#pragma unroll
          for (int d = 0; d < 4; ++d) O[d][r] *= a; } }
    LAS float* xch = (LAS float*)lds + rg * 4096;
    if (c == 1) {
#pragma unroll
        for (int d = 0; d < 4; ++d)
#pragma unroll
            for (int r = 0; r < 16; ++r) xch[(d * 16 + r) * 64 + lane_e] = O[d][r];
    }
    __syncthreads();
    if (c == 0) {
        float ssq[16];
#pragma unroll
        for (int r = 0; r < 16; ++r) { float s = 0.f;
#pragma unroll
            for (int d = 0; d < 4; ++d) { O[d][r] += xch[(d * 16 + r) * 64 + lane_e]; s += O[d][r] * O[d][r]; }
            ssq[r] = s; }
#pragma unroll
        for (int o = 1; o < 32; o <<= 1)
#pragma unroll
            for (int r = 0; r < 16; ++r) ssq[r] += __shfl_xor(ssq[r], o);
        float gsc[4];
#pragma unroll
        for (int d = 0; d < 4; ++d) gsc[d] = subg[h * 128 + 32 * d + r32e] * (1.f - LAMBDA_INIT);
        bf16_t* ob = OA + (brow0 + q0) * CCH + h * 128;
        const unsigned off0 = (unsigned)((32 * rg + 4 * hie) * CCH + r32e);
#pragma unroll
        for (int r = 0; r < 16; ++r) { const float rs = __builtin_amdgcn_rsqf(ssq[r] * (1.f / 128.f) + EPS);
            const unsigned offr = off0 + (unsigned)(((r & 3) + 8 * (r >> 2)) * CCH);
#pragma unroll
            for (int d = 0; d < 4; ++d) ob[offr + 32 * d] = (bf16_t)(cvtpk(O[d][r] * rs * gsc[d], 0.f) & 0xffffu);
            asm volatile("" ::: "memory"); }
    }
    __syncthreads();
}

struct Args {
    const float *x, *p, *ln0g, *ln0b, *w_in, *conv_w, *cln_g, *cln_b, *w_conv_out, *lq1, *lk1, *lq2, *lk2, *subg, *w_attn_out, *w_o,
                *ln1g, *ln1b, *w_ff1, *w_ff2, *w_ple, *w_pg, *ln2g, *ln2b;
    float* out; unsigned char* ws; int ph_lo, ph_hi, rep, pad;
};
constexpr int NPHASE = 9;
#ifndef REP_ATT
#define REP_ATT 1
#endif
#ifndef REP_P1
#define REP_P1 1
#endif
#ifndef REP_CONV
#define REP_CONV 1
#endif
#ifndef REP_P0
#define REP_P0 1
#endif

__global__ void __launch_bounds__(NTHR, 2) fwd_kernel(Args a) {
    extern __shared__ __attribute__((aligned(16))) unsigned char lds_raw[];
    LAS unsigned char* lds = (LAS unsigned char*)lds_raw;
    const int tid = threadIdx.x, lane = tid & 63, wid = __builtin_amdgcn_readfirstlane(tid >> 6);
    const int G = gridDim.x, bx = blockIdx.x;
    const int vcu = (G % 8 == 0) ? (bx % 8) * (G / 8) + bx / 8 : bx;
    const int gw = vcu * NWAVES + wid, ngw = G * NWAVES;
    unsigned char* ws = a.ws;
    bf16_t* Zb = (bf16_t*)(ws + WS_Z); bf16_t* FF1 = (bf16_t*)(ws + WS_Z);
    bf16_t *WIN = (bf16_t*)(ws + WS_WIN), *WFF1 = (bf16_t*)(ws + WS_WFF1), *WFF2 = (bf16_t*)(ws + WS_WFF2), *WO = (bf16_t*)(ws + WS_WO),
           *WC = (bf16_t*)(ws + WS_WC), *WA = (bf16_t*)(ws + WS_WA), *WPLE = (bf16_t*)(ws + WS_WPLE);
    float *ST0 = (float*)(ws + WS_ST0), *ST1 = (float*)(ws + WS_ST1); unsigned* CTL = (unsigned*)(ws + WS_CTL);
    bf16_t *HB = (bf16_t*)(ws + WS_HB), *PE = (bf16_t*)(ws + WS_PE), *PB = (bf16_t*)(ws + WS_PB);
    bf16_t *UC = (bf16_t*)a.out, *OA = (bf16_t*)a.out + (size_t)M_ * CCH;
    const int lo = a.ph_lo, hi = a.ph_hi;
    cg::grid_group grid = cg::this_grid();
#define IN(k) (lo <= (k) && (k) < hi)
#define SEAM(k) do { if (IN(k) && IN((k) + 1)) grid.sync(); } while (0)

    if (IN(0)) for (int rep = 0; rep < REP_P0; ++rep) {
        LAS float* scr = (LAS float*)(lds + wid * 16384);
        if (bx == 0 && tid < 128) CTL[tid] = 0u;
        constexpr int I_IN = 16 * 144, I_C = 8 * 32, I_A = 8 * 32, I_O = 16 * 32, I_F1 = 16 * 128, I_PG = 16 * 32, I_F2 = 64 * 32, I_PL = 4 * 32;
        constexpr int NIT = I_IN + I_C + I_A + I_O + I_F1 + I_PG + I_F2 + I_PL;
        for (int it = gw; it < NIT; it += ngw) {
            int r = it;
            if (r < I_IN) { transpose_item(a.w_in, DM, NIN, WIN, 0, scr, r, lane); continue; } r -= I_IN;
            if (r < I_C) { transpose_item(a.w_conv_out, CCH, DM, WC, 0, scr, r, lane); continue; } r -= I_C;
            if (r < I_A) { transpose_item(a.w_attn_out, CCH, DM, WA, 0, scr, r, lane); continue; } r -= I_A;
            if (r < I_O) { transpose_item(a.w_o, DM, DM, WO, 0, scr, r, lane); continue; } r -= I_O;
            if (r < I_F1) { transpose_item(a.w_ff1, DM, DFF, WFF1, 0, scr, r, lane); continue; } r -= I_F1;
            if (r < I_PG) { transpose_item(a.w_pg, DM, DM, WFF1, DFF, scr, r, lane); continue; } r -= I_PG;
            if (r < I_F2) { transpose_item(a.w_ff2, DFF, DM, WFF2, 0, scr, r, lane); continue; } r -= I_F2;
            transpose_item(a.w_ple, PLED, DM, WPLE, 0, scr, r, lane);
        }
        ln_rows<0>(a.x, HB, nullptr, ST0, a.ln0g, a.ln0b, gw, ngw, lane);
        for (size_t i = (size_t)(vcu * NTHR + tid); i < (size_t)M_ * PLED / 8; i += (size_t)G * NTHR) {
            const f32x4 v0 = *((const f32x4*)a.p + 2 * i), v1 = *((const f32x4*)a.p + 2 * i + 1);
            *((u32x4*)PB + i) = pack8(v0, v1);
        }
    }
    SEAM(0);
    if (IN(1)) for (int rep = 0; rep < REP_P1; ++rep) {
        { pg8::Gemm g{HB, WIN, M_, NIN, DM}; pg8::StaticOrder S; S.init(M_, NIN, G, bx); EpiZ E{Zb, NIN, 0, CTL + 64};
          pg8::gemm_phase<EpiZ, pg8::StaticOrder, true, true>(lds, g, S, E); }
        { pg8::Gemm g{PB, WPLE, M_, DM, PLED}; pg8::StaticOrder S; S.init(M_, DM, G, bx); EpiZ E{PE, DM, 1, nullptr};
          pg8::gemm_phase<EpiZ, pg8::StaticOrder, true, true>(lds, g, S, E); }
    }
    SEAM(1);
    if (IN(2)) {
        float lam;
        { const float a1 = wave_sum(a.lq1[lane] * a.lk1[lane]), a2 = wave_sum(a.lq2[lane] * a.lk2[lane]); lam = expf(a1) - expf(a2) + LAMBDA_INIT; }
        LAS unsigned* qw = (LAS unsigned*)(lds + A_SCR + 1024 + 64);
        for (;;) {
            if (tid == 0) *qw = atomicAdd(CTL + 2 * a.rep, 1u);
            __syncthreads();
            const int u = (int)*qw;
            __syncthreads();
            if (u >= 1024) break;
            const int qb = 63 - (u >> 4), bh = u & 15; attn_unit(lds, Zb, OA, a.subg, CTL + 64, bh >> 2, bh & 3, qb, lam);
        }
        for (;;) {
            if (tid == 0) *qw = atomicAdd(CTL + 2 * a.rep + 1, 1u);
            __syncthreads();
            const int u = (int)*qw;
            __syncthreads();
            if (u >= 1024) break;
            conv_unit(lds, Zb, UC, a.conv_w, a.cln_g, a.cln_b, u);
        }
    }
    SEAM(2);
    if (IN(3)) {
        { pg8::Gemm g{UC, WC, M_, DM, CCH}; pg8::StaticOrder S; S.init(M_, DM, G, bx); EpiGate E{HB, Zb, ZGC, 0};
          pg8::gemm_phase<EpiGate, pg8::StaticOrder, true, true>(lds, g, S, E); }
        { pg8::Gemm g{OA, WA, M_, DM, CCH}; pg8::StaticOrder S; S.init(M_, DM, G, bx); EpiGate E{HB, Zb, ZGA, 1};
          pg8::gemm_phase<EpiGate, pg8::StaticOrder, true, true>(lds, g, S, E); }
    }
    SEAM(3);
    if (IN(4)) {
        pg8::Gemm g{HB, WO, M_, DM, DM}; pg8::StaticOrder S; S.init(M_, DM, G, bx); EpiRes E{a.x, ST0, a.ln0g, a.ln0b, nullptr, a.out};
        pg8::gemm_phase<EpiRes, pg8::StaticOrder, true, true>(lds, g, S, E);
    }
    SEAM(4);
    if (IN(5)) ln_rows<0>(a.out, HB, nullptr, ST1, a.ln1g, a.ln1b, gw, ngw, lane);
    SEAM(5);
    if (IN(6)) {
        pg8::Gemm g{HB, WFF1, M_, DFF + DM, DM}; pg8::StaticOrder S; S.init(M_, DFF + DM, G, bx); EpiFF1 E{FF1, PE};
        pg8::gemm_phase<EpiFF1, pg8::StaticOrder, true, true>(lds, g, S, E);
    }
    SEAM(6);
    if (IN(7)) {
        pg8::Gemm g{FF1, WFF2, M_, DM, DFF}; pg8::StaticOrder S; S.init(M_, DM, G, bx); EpiRes E{a.out, ST1, a.ln1g, a.ln1b, PE, a.out};
        pg8::gemm_phase<EpiRes, pg8::StaticOrder, true, true>(lds, g, S, E);
    }
    SEAM(7);
    if (IN(8)) ln_rows<1>(a.out, nullptr, a.out, nullptr, a.ln2g, a.ln2b, gw, ngw, lane);
#undef IN
#undef SEAM
}

#ifndef REP_PHASE
#define REP_PHASE -1
#endif
#ifndef N_LAUNCH_MODE
#define N_LAUNCH_MODE 0
#endif
extern "C" void kernel_launch(void* const* d_in, const int* in_sizes, int n_in, void* d_out, int out_size, void* d_ws, size_t ws_size, hipStream_t stream) {
    static int grid = 0;
    if (grid == 0) {
        int dev = 0, cus = 0, per_cu = 0;
        if (n_in != 24 || out_size != M_ * DM || ws_size < WS_END) { fprintf(stderr, "kernel_launch: unexpected shapes (n_in %d out %d ws %zu)\n", n_in, out_size, ws_size); grid = -1; return; }
        (void)hipGetDevice(&dev); (void)hipDeviceGetAttribute(&cus, hipDeviceAttributeMultiprocessorCount, dev);
        if (hipFuncSetAttribute((const void*)fwd_kernel, hipFuncAttributeMaxDynamicSharedMemorySize, LDS_BYTES) != hipSuccess) { fprintf(stderr, "kernel_launch: hipFuncSetAttribute failed\n"); grid = -1; return; }
        if (hipOccupancyMaxActiveBlocksPerMultiprocessor(&per_cu, (const void*)fwd_kernel, NTHR, LDS_BYTES) != hipSuccess || per_cu < 1) { fprintf(stderr, "kernel_launch: occupancy query says %d\n", per_cu); per_cu = 1; }
        (void)hipGetLastError();
        grid = cus * 1;
        if (per_cu < 1) grid = cus;
    }
    if (grid < 0) return;
    Args a{};
    const float** f = (const float**)&a;
    for (int i = 0; i < 24; ++i) f[i] = (const float*)d_in[i];
    a.out = (float*)d_out; a.ws = (unsigned char*)d_ws;
#if N_LAUNCH_MODE == 0
    a.ph_lo = 0; a.ph_hi = NPHASE;
    void* args[] = {&a};
    hipError_t e = hipLaunchCooperativeKernel((const void*)fwd_kernel, dim3(grid), dim3(NTHR), args, LDS_BYTES, stream);
    if (e != hipSuccess) fprintf(stderr, "cooperative launch failed: %s (grid %d)\n", hipGetErrorString(e), grid);
#else
    for (int ph = 0; ph < NPHASE; ++ph) { a.ph_lo = ph; a.ph_hi = ph + 1; hipLaunchKernelGGL(fwd_kernel, dim3(grid), dim3(NTHR), LDS_BYTES, stream, a);
        if (ph == REP_PHASE) { a.rep = 1; hipLaunchKernelGGL(fwd_kernel, dim3(grid), dim3(NTHR), LDS_BYTES, stream, a); a.rep = 0; } }
#endif
}
```
